# Optimizing an MI355X kernel written in HIP

```python
import math
import jax, jax.numpy as jnp
from jax import lax
import numpy as np

D_MODEL = 1024
BATCH = 8
SEQ = 2048
DEPTH = 2
DEC_BATCH = 128
DEC_SEQ = 1
PAST_LEN = 16384
PAGE_SIZE = 128

N_META = 16
D_CONV = D_MODEL
CONV_W = 3
GLA_HEADS = 4
GLA_KDIM = D_MODEL // 2
GLA_VDIM = D_MODEL
GLA_DK = GLA_KDIM // GLA_HEADS
GLA_DV = GLA_VDIM // GLA_HEADS
GATE_RANK = 16
GATE_NORMALIZER = 16.0
CHUNK = 64
D_FF = -(-8 * D_MODEL // (3 * 256)) * 256
EPS = 1e-6
SPLIT_SIZES = (D_CONV, D_CONV, D_CONV, GLA_KDIM, GLA_KDIM, GLA_VDIM, GLA_VDIM, GATE_RANK, D_MODEL, D_MODEL)
D_IN = sum(SPLIT_SIZES)
SPLIT_IDX = tuple(int(s) for s in np.cumsum(SPLIT_SIZES)[:-1])

kernel_name = "hybrid_shortconv_gla_gated_merge_step"


def rmsnorm(x, g):
    xf = x.astype(jnp.float32)
    y = xf * lax.rsqrt(jnp.mean(xf * xf, axis=-1, keepdims=True) + EPS) * g.astype(jnp.float32)
    return y.astype(x.dtype)


def to_heads(a, d):
    b, t, _ = a.shape
    return a.reshape(b, t, -1, d).transpose(0, 2, 1, 3)


def gla_chunk(S, q, k, v, g):
    L = q.shape[2]
    b = jnp.cumsum(g, axis=2)
    causal = jnp.tril(jnp.ones((L, L), dtype=bool))[:, :, None]
    diff = b[:, :, :, None, :] - b[:, :, None, :, :]
    decay = jnp.where(causal, jnp.exp(jnp.where(causal, diff, 0.0)), 0.0)
    A = jnp.einsum('bhtd,bhsd,bhtsd->bhts', q, k, decay)
    o = jnp.einsum('bhts,bhsv->bhtv', A, v) + jnp.einsum('bhtd,bhdv->bhtv', q * jnp.exp(b), S)
    b_last = b[:, :, -1:, :]
    S_new = jnp.exp(b_last[:, :, 0, :])[..., None] * S + jnp.einsum('bhsd,bhsv->bhdv', k * jnp.exp(b_last - b), v)
    return S_new, o


def gla_scan(S0, q, k, v, g, chunk):
    bsz, h, L, _ = q.shape
    c = min(chunk, L)
    n = -(-L // c)
    pad = n * c - L

    def blocks(a):
        a = jnp.pad(a, ((0, 0), (0, 0), (0, pad), (0, 0)))
        return a.reshape(bsz, h, n, c, a.shape[-1]).transpose(2, 0, 1, 3, 4)

    S, o = lax.scan(lambda s, xs: gla_chunk(s, *xs), S0, (blocks(q), blocks(k), blocks(v), blocks(g)))
    o = o.transpose(1, 2, 0, 3, 4).reshape(bsz, h, n * c, -1)[:, :, :L]
    return S, o


def mixer(xn, conv_prev, S0, n_lead, w_in, conv_w, w_gk2, b_gk2, gla_gain, w_a_out, w_b_out, w_o):
    bsz, T, _ = xn.shape
    proj = xn @ w_in
    gB, gC, h, q, k, v, og, z, ga, gb = jnp.split(proj, SPLIT_IDX, axis=-1)
    u = gC * h
    up = jnp.concatenate([conv_prev.astype(u.dtype), u], axis=1)
    cw = conv_w.astype(u.dtype)
    yconv = cw[0] * up[:, :T] + cw[1] * up[:, 1:T + 1] + cw[2] * up[:, 2:T + 2]
    conv_new = up[:, T:]
    ya = (gB * yconv) @ w_a_out
    gk = jax.nn.log_sigmoid((z @ w_gk2 + b_gk2).astype(jnp.float32)) / GATE_NORMALIZER
    qh = to_heads(q, GLA_DK).astype(jnp.float32) * (GLA_DK ** -0.5)
    kh = to_heads(k, GLA_DK).astype(jnp.float32)
    vh = to_heads(v, GLA_DV).astype(jnp.float32)
    gh = to_heads(gk, GLA_DK)
    S0 = S0.astype(jnp.float32)
    if n_lead > 0:
        S, o_lead = gla_scan(S0, qh[:, :, :n_lead], kh[:, :, :n_lead], vh[:, :, :n_lead], gh[:, :, :n_lead], n_lead)
        S, o_rest = gla_scan(S, qh[:, :, n_lead:], kh[:, :, n_lead:], vh[:, :, n_lead:], gh[:, :, n_lead:], CHUNK)
        o = jnp.concatenate([o_lead, o_rest], axis=2)
    else:
        S, o = gla_scan(S0, qh, kh, vh, gh, CHUNK)
    o = rmsnorm(o, gla_gain)
    o = o.transpose(0, 2, 1, 3).reshape(bsz, T, GLA_VDIM).astype(xn.dtype)
    yb = (o * jax.nn.silu(og)) @ w_b_out
    m = jax.nn.sigmoid(ga) * ya + jax.nn.sigmoid(gb) * yb
    return m @ w_o, conv_new, S


def swiglu(xn, w_gu, w_down):
    g, u = jnp.split(xn @ w_gu, 2, axis=-1)
    return (jax.nn.silu(g) * u) @ w_down


def trunk(x, conv_states, gla_states, n_lead, w_in, conv_w, w_gk2, b_gk2, gla_gain,
          w_a_out, w_b_out, w_o, norm_mix, norm_ffn, w_gu, w_down, final_norm):
    conv_out, gla_out = [], []
    for l in range(DEPTH):
        mo, cs, gs = mixer(rmsnorm(x, norm_mix[l]), conv_states[l], gla_states[l], n_lead,
                           w_in[l], conv_w[l], w_gk2[l], b_gk2[l], gla_gain[l],
                           w_a_out[l], w_b_out[l], w_o[l])
        x = x + mo
        x = x + swiglu(rmsnorm(x, norm_ffn[l]), w_gu[l], w_down[l])
        conv_out.append(cs)
        gla_out.append(gs)
    return rmsnorm(x, final_norm), jnp.stack(conv_out), jnp.stack(gla_out)


def setup_inputs(seed: int = 0) -> dict:
    key = jax.random.key(seed)
    ks = jax.random.split(key, 20)
    nrm = lambda k, shape, s: jax.random.normal(k, shape, jnp.float32) * s
    return {
        "x_prompt": nrm(ks[0], (BATCH, SEQ, D_MODEL), 1.0),
        "x_sample": nrm(ks[1], (DEC_BATCH, DEC_SEQ, D_MODEL), 1.0),
        "state_conv": nrm(ks[2], (DEPTH, DEC_BATCH, CONV_W - 1, D_CONV), 1.0),
        "state_gla": nrm(ks[3], (DEPTH, DEC_BATCH, GLA_HEADS, GLA_DK, GLA_DV), 0.1),
        "meta_tokens": nrm(ks[4], (N_META, D_MODEL), 1.0),
        "w_in": nrm(ks[5], (DEPTH, D_MODEL, D_IN), D_MODEL ** -0.5),
        "conv_w": nrm(ks[6], (DEPTH, CONV_W, D_CONV), CONV_W ** -0.5),
        "w_gk2": nrm(ks[7], (DEPTH, GATE_RANK, GLA_KDIM), GATE_RANK ** -0.5),
        "b_gk2": nrm(ks[8], (DEPTH, GLA_KDIM), 0.1),
        "gla_gain": 1.0 + nrm(ks[9], (DEPTH, GLA_DV), 0.01),
        "w_a_out": nrm(ks[10], (DEPTH, D_CONV, D_MODEL), D_CONV ** -0.5),
        "w_b_out": nrm(ks[11], (DEPTH, GLA_VDIM, D_MODEL), GLA_VDIM ** -0.5),
        "w_o": nrm(ks[12], (DEPTH, D_MODEL, D_MODEL), D_MODEL ** -0.5),
        "norm_mix": 1.0 + nrm(ks[13], (DEPTH, D_MODEL), 0.01),
        "norm_ffn": 1.0 + nrm(ks[14], (DEPTH, D_MODEL), 0.01),
        "w_gu": nrm(ks[15], (DEPTH, D_MODEL, 2 * D_FF), D_MODEL ** -0.5),
        "w_down": nrm(ks[16], (DEPTH, D_FF, D_MODEL), D_FF ** -0.5),
        "final_norm": 1.0 + nrm(ks[17], (D_MODEL,), 0.01),
    }


def reference(x_prompt, x_sample, state_conv, state_gla, meta_tokens, w_in, conv_w, w_gk2, b_gk2,
              gla_gain, w_a_out, w_b_out, w_o, norm_mix, norm_ffn, w_gu, w_down, final_norm):
    weights = (w_in, conv_w, w_gk2, b_gk2, gla_gain, w_a_out, w_b_out, w_o,
               norm_mix, norm_ffn, w_gu, w_down, final_norm)
    bsz = x_prompt.shape[0]
    meta = jnp.broadcast_to(meta_tokens.astype(x_prompt.dtype)[None], (bsz, N_META, D_MODEL))
    xp = jnp.concatenate([meta, x_prompt], axis=1)
    conv0 = jnp.zeros((DEPTH, bsz, CONV_W - 1, D_CONV), x_prompt.dtype)
    gla0 = jnp.zeros((DEPTH, bsz, GLA_HEADS, GLA_DK, GLA_DV), jnp.float32)
    yp, p_conv, p_gla = trunk(xp, conv0, gla0, N_META, *weights)
    y_prompt = yp[:, N_META:]
    y_sample, s_conv, s_gla = trunk(x_sample, state_conv, state_gla, 0, *weights)
    return (y_prompt, y_sample, p_conv, p_gla.astype(x_prompt.dtype),
            s_conv.astype(state_conv.dtype), s_gla.astype(state_gla.dtype))
```

```cpp
#include <hip/hip_runtime.h>
#include <hip/hip_cooperative_groups.h>
#include <cstdio>
#include <cstdint>
namespace cg = cooperative_groups;
namespace pg8 {
#define PG8_LAS __attribute__((address_space(3)))
typedef unsigned short bf16_t;
typedef short bf16x8 __attribute__((ext_vector_type(8)));
typedef float f32x4 __attribute__((ext_vector_type(4)));
typedef unsigned u32x4 __attribute__((ext_vector_type(4)));
constexpr int BM = 256, BK = 64, HALF = 128, HTB = HALF * BK * 2  , STAGE_BYTES = 8 * HTB, NXCD = 8, WGM = 8;

__host__ __device__ __forceinline__ int lds_byte(int r, int c) { const int st = (r >> 4) * 2 + (c >> 5), rr = r & 15, cc = c & 31, ob = rr * 64 + cc * 2; return st * 1024 + (ob ^ (((ob >> 9) & 1) << 5)); }
__host__ __device__ __forceinline__ void stage_rc(int b, int& R, int& C) { const int st = b / 1024, sb = b % 1024, swz = sb ^ (((sb >> 9) & 1) << 5); R = (st >> 1) * 16 + swz / 64; C = (st & 1) * 32 + (swz % 64) / 2; }
__host__ __device__ __forceinline__ int perm32(int rho) { const int n = rho >> 4, i = rho & 15; return 8 * (i >> 2) + 4 * n + (i & 3); }

struct Unit { int pm, pn, seg; };
struct Gemm { const bf16_t* A; const bf16_t* Bt; int M, N, K; const bf16_t* A2 = nullptr; const bf16_t* Bt2 = nullptr; };

struct StaticOrder {
    int nM, nN, nwg, G, c;
    __host__ __device__ void init(int M, int N, int G_, int c_) { nM = M / BM; nN = N / BM; nwg = nM * nN; G = G_; c = c_; }
    __host__ __device__ bool next(int i, Unit& u) const {
        const long L = (long)i * G + c; if (L >= nwg) return false;
        int wgid = (int)L; { const int q = nwg / NXCD, r = nwg % NXCD, xcd = wgid % NXCD, off = wgid / NXCD; wgid = (xcd < r ? xcd * (q + 1) : r * (q + 1) + (xcd - r) * q) + off; }
        const int nig = WGM * nN, gid = wgid / nig, fm = gid * WGM, gsz = (nM - fm) < WGM ? (nM - fm) : WGM;
        u.pm = fm + ((wgid % nig) % gsz); u.pn = (wgid % nig) / gsz; u.seg = 0; return true;
    }
    __device__ __forceinline__ void a_ready(const Unit&) const {}
    __device__ __forceinline__ void done(const Unit&) const {}
};

__device__ __forceinline__ unsigned cvt_pk_bf16(float lo, float hi) { unsigned r; asm volatile("v_cvt_pk_bf16_f32 %0, %1, %2" : "=v"(r) : "v"(lo), "v"(hi)); return r; }
typedef float f32x2 __attribute__((ext_vector_type(2)));
}
constexpr int M_ROWS = 16640, NREAL = 16384, NPROMPT = 16512, DM = 1024, DFF = 2816, NPROJ = 8192, NGEMM1 = 8704;
constexpr float EPS = 1e-6f;
constexpr int C_GB = 0, C_GC = 1024, C_H = 2048, C_Q = 3072, C_K = 3584, C_V = 4096, C_OG = 5120, C_GA = 6144, C_GBB = 7168;

#define LAS __attribute__((address_space(3)))
#define GP(T, i) ((T*)(__attribute__((address_space(1))) T*)kp[i])
typedef unsigned short bf16_t;
typedef short bf16x8 __attribute__((ext_vector_type(8)));
typedef float f32x4 __attribute__((ext_vector_type(4)));
typedef unsigned u32x4 __attribute__((ext_vector_type(4)));
typedef unsigned u32x2 __attribute__((ext_vector_type(2)));

typedef __bf16 bf16v2_t __attribute__((ext_vector_type(2)));
typedef float f32v2_t __attribute__((ext_vector_type(2)));
__device__ __forceinline__ unsigned pk_bf16(float lo, float hi) { const f32v2_t v = {lo, hi}; const bf16v2_t b = __builtin_convertvector(v, bf16v2_t); return __builtin_bit_cast(unsigned, b); }
__device__ __forceinline__ float bflo(unsigned w) { return __uint_as_float(w << 16); }
__device__ __forceinline__ float bfhi(unsigned w) { return __uint_as_float(w & 0xffff0000u); }
__device__ __forceinline__ float bf2f(bf16_t h) { return __uint_as_float((unsigned)h << 16); }
__device__ __forceinline__ bf16_t f2bf(float f) { return (bf16_t)(pk_bf16(f, 0.f) & 0xffffu); }
__device__ __forceinline__ float sigm(float x) { return __builtin_amdgcn_rcpf(1.f + __expf(-x)); }
__device__ __forceinline__ float silu(float x) { return x * __builtin_amdgcn_rcpf(1.f + __expf(-x)); }
__device__ __forceinline__ float logsig(float x) { return fminf(x, 0.f) - __logf(1.f + __expf(-fabsf(x))); }
__device__ __forceinline__ int ltid() { int t = threadIdx.x; asm volatile("" : "+v"(t)); return t; }
__device__ __forceinline__ float* xrow(float* dout, float* xtail, int row) { return row < NREAL ? dout + (size_t)row * DM : xtail + (size_t)(row - NREAL) * DM; }

namespace pg8 {
struct EpiProj { static constexpr bool IDEMPOTENT = true;
    static constexpr bool PERM = true, AFTER_DRAIN = false;
    bf16_t* proj; float* gk; const float* ss; const float* bgk;
    __device__ __forceinline__ void operator()(const f32x4 (&acc)[2][2][4][2], const Unit& u, int wr, int wc, int fr, int fq) const {
        const int row0 = u.pm * BM + wr * 64 + fr, cw = wc * 32 + 8 * fq;
        float rsv[2][4];
#pragma unroll
        for (int ai = 0; ai < 2; ++ai)
#pragma unroll
            for (int m = 0; m < 4; ++m) rsv[ai][m] = ss[row0 + ai * HALF + m * 16];
        asm volatile("" ::: "memory");
        if (u.pn < 32) {
#pragma unroll
            for (int ai = 0; ai < 2; ++ai)
#pragma unroll
                for (int m = 0; m < 4; ++m) { const int row = row0 + ai * HALF + m * 16; const float rs = rsqrtf(rsv[ai][m] * (1.f / DM) + EPS);
                    bf16_t* rp = proj + (size_t)row * NPROJ + u.pn * BM + cw;
#pragma unroll
                    for (int bj = 0; bj < 2; ++bj) { const f32x4 v0 = acc[ai][bj][m][0] * rs, v1 = acc[ai][bj][m][1] * rs; u32x4 w;
                        w.x = pk_bf16(v0[0], v0[1]); w.y = pk_bf16(v0[2], v0[3]); w.z = pk_bf16(v1[0], v1[1]); w.w = pk_bf16(v1[2], v1[3]); *(u32x4*)(rp + bj * HALF) = w; } }
        } else {
            const int cg0 = (u.pn - 32) * BM + cw;
#pragma unroll
            for (int bj = 0; bj < 2; ++bj) { const f32x4 b0 = *(const f32x4*)(bgk + cg0 + bj * HALF), b1 = *(const f32x4*)(bgk + cg0 + bj * HALF + 4);
#pragma unroll
                for (int ai = 0; ai < 2; ++ai)
#pragma unroll
                    for (int m = 0; m < 4; ++m) { const int row = row0 + ai * HALF + m * 16; const float rs = rsqrtf(rsv[ai][m] * (1.f / DM) + EPS);
                        f32x4 v0 = acc[ai][bj][m][0] * rs + b0, v1 = acc[ai][bj][m][1] * rs + b1;
#pragma unroll
                        for (int e = 0; e < 4; ++e) { v0[e] = logsig(v0[e]) * 0.0625f; v1[e] = logsig(v1[e]) * 0.0625f; }
                        float* gp = gk + (size_t)row * 512 + cg0 + bj * HALF; *(f32x4*)gp = v0; *(f32x4*)(gp + 4) = v1; } }
        }
    }
};
template <bool ADD> struct EpiGate { static constexpr bool IDEMPOTENT = false;
    static constexpr bool PERM = true, AFTER_DRAIN = false;
    const bf16_t* gate; bf16_t* mb;
    __device__ __forceinline__ void operator()(const f32x4 (&acc)[2][2][4][2], const Unit& u, int wr, int wc, int fr, int fq) const {
        const int row0 = u.pm * BM + wr * 64 + fr, col0 = u.pn * BM + wc * 32 + 8 * fq;
#pragma unroll
        for (int am = 0; am < 4; ++am) { const int ai = am >> 1, mb0 = (am & 1) * 2;
            u32x4 gv[4][2], ov[4][2];
#pragma unroll
            for (int m = mb0; m < mb0 + 2; ++m)
#pragma unroll
                for (int bj = 0; bj < 2; ++bj) { const int row = row0 + ai * HALF + m * 16; gv[m][bj] = __builtin_nontemporal_load((const u32x4*)(gate + (size_t)row * NPROJ + col0 + bj * HALF));
                    if (ADD) ov[m][bj] = *(const u32x4*)(mb + (size_t)row * DM + col0 + bj * HALF); }
            asm volatile("" ::: "memory");
#pragma unroll
            for (int m = mb0; m < mb0 + 2; ++m)
#pragma unroll
                for (int bj = 0; bj < 2; ++bj) { const int row = row0 + ai * HALF + m * 16; const u32x4 g = gv[m][bj]; bf16_t* op = mb + (size_t)row * DM + col0 + bj * HALF;
                    const f32x4 a0 = acc[ai][bj][m][0], a1 = acc[ai][bj][m][1];
                    float r0 = sigm(bflo(g.x)) * a0[0], r1 = sigm(bfhi(g.x)) * a0[1], r2 = sigm(bflo(g.y)) * a0[2], r3 = sigm(bfhi(g.y)) * a0[3];
                    float r4 = sigm(bflo(g.z)) * a1[0], r5 = sigm(bfhi(g.z)) * a1[1], r6 = sigm(bflo(g.w)) * a1[2], r7 = sigm(bfhi(g.w)) * a1[3];
                    if (ADD) { const u32x4 o = ov[m][bj]; r0 += bflo(o.x); r1 += bfhi(o.x); r2 += bflo(o.y); r3 += bfhi(o.y); r4 += bflo(o.z); r5 += bfhi(o.z); r6 += bflo(o.w); r7 += bfhi(o.w); }
                    u32x4 w; w.x = pk_bf16(r0, r1); w.y = pk_bf16(r2, r3); w.z = pk_bf16(r4, r5); w.w = pk_bf16(r6, r7); *(u32x4*)op = w; }
        }
    }
};
struct PairOrder : StaticOrder {
    __host__ __device__ bool next(int i, Unit& u) const { if (!StaticOrder::next(i >> 1, u)) return false; u.seg = i & 1; return true; }
};
struct EpiGate2 { static constexpr bool IDEMPOTENT = false;
    static constexpr bool PERM = true, AFTER_DRAIN = false;
    const bf16_t* gateA; const bf16_t* gateB; bf16_t* mb;
    __device__ __forceinline__ void operator()(const f32x4 (&acc)[2][2][4][2], const Unit& u, int wr, int wc, int fr, int fq) const {
        if (u.seg == 0) { EpiGate<false> e{gateA, mb}; e(acc, u, wr, wc, fr, fq); } else { EpiGate<true> e{gateB, mb}; e(acc, u, wr, wc, fr, fq); }
    }
};
struct EpiResid { static constexpr bool IDEMPOTENT = false;
    static constexpr bool PERM = true, AFTER_DRAIN = false;
    bf16_t* xb; float* ssn;
    __device__ __forceinline__ void operator()(const f32x4 (&acc)[2][2][4][2], const Unit& u, int wr, int wc, int fr, int fq) const {
        const int row0 = u.pm * BM + wr * 64 + fr, col0 = u.pn * BM + wc * 32 + 8 * fq;
#pragma unroll
        for (int ai = 0; ai < 2; ++ai) {
            u32x4 xv[4][2];
#pragma unroll
            for (int m = 0; m < 4; ++m)
#pragma unroll
                for (int bj = 0; bj < 2; ++bj) xv[m][bj] = *(const u32x4*)(xb + (size_t)(row0 + ai * HALF + m * 16) * DM + col0 + bj * HALF);
            asm volatile("" ::: "memory");
#pragma unroll
            for (int m = 0; m < 4; ++m) { const int row = row0 + ai * HALF + m * 16; bf16_t* bp = xb + (size_t)row * DM + col0; float s = 0.f;
#pragma unroll
                for (int bj = 0; bj < 2; ++bj) { const u32x4 o = xv[m][bj]; const f32x4 a0 = acc[ai][bj][m][0], a1 = acc[ai][bj][m][1];
                    u32x4 w; w.x = pk_bf16(bflo(o.x) + a0[0], bfhi(o.x) + a0[1]); w.y = pk_bf16(bflo(o.y) + a0[2], bfhi(o.y) + a0[3]);
                    w.z = pk_bf16(bflo(o.z) + a1[0], bfhi(o.z) + a1[1]); w.w = pk_bf16(bflo(o.w) + a1[2], bfhi(o.w) + a1[3]); *(u32x4*)(bp + bj * HALF) = w;
                    const float r0 = bflo(w.x), r1 = bfhi(w.x), r2 = bflo(w.y), r3 = bfhi(w.y), r4 = bflo(w.z), r5 = bfhi(w.z), r6 = bflo(w.w), r7 = bfhi(w.w);
                    s += (r0 * r0 + r1 * r1) + (r2 * r2 + r3 * r3) + (r4 * r4 + r5 * r5) + (r6 * r6 + r7 * r7); }
                s += __shfl_xor(s, 16); s += __shfl_xor(s, 32);
                if (fq == 0) atomicAdd(ssn + row, s); }
        }
    }
};
struct EpiSwiglu { static constexpr bool IDEMPOTENT = true;
    static constexpr bool PERM = true, AFTER_DRAIN = false;
    bf16_t* hb; const float* ss;
    __device__ __forceinline__ void operator()(const f32x4 (&acc)[2][2][4][2], const Unit& u, int wr, int wc, int fr, int fq) const {
        const int row0 = u.pm * BM + wr * 64 + fr, col0 = u.pn * HALF + wc * 32 + 8 * fq;
        float rsv[2][4];
#pragma unroll
        for (int ai = 0; ai < 2; ++ai)
#pragma unroll
            for (int m = 0; m < 4; ++m) rsv[ai][m] = ss[row0 + ai * HALF + m * 16];
        asm volatile("" ::: "memory");
#pragma unroll
        for (int ai = 0; ai < 2; ++ai)
#pragma unroll
            for (int m = 0; m < 4; ++m) { const int row = row0 + ai * HALF + m * 16; const float rs = rsqrtf(rsv[ai][m] * (1.f / DM) + EPS);
                const f32x4 g0 = acc[ai][0][m][0] * rs, g1 = acc[ai][0][m][1] * rs, u0 = acc[ai][1][m][0] * rs, u1 = acc[ai][1][m][1] * rs;
                u32x4 w; w.x = pk_bf16(silu(g0[0]) * u0[0], silu(g0[1]) * u0[1]); w.y = pk_bf16(silu(g0[2]) * u0[2], silu(g0[3]) * u0[3]);
                w.z = pk_bf16(silu(g1[0]) * u1[0], silu(g1[1]) * u1[1]); w.w = pk_bf16(silu(g1[2]) * u1[2], silu(g1[3]) * u1[3]);
                *(u32x4*)(hb + (size_t)row * DFF + col0) = w; }
    }
};
}
namespace pg8 {
template <class Epi, class Sched, bool ALIGN_EPI = false, bool SP2 = false>
__device__ __forceinline__ void gemm_phase(PG8_LAS unsigned char* lds, const Gemm g, const Sched& S, const Epi& E) {
    const int tid = ltid(), wid = __builtin_amdgcn_readfirstlane(tid >> 6), lane = tid & 63, wr = wid >> 2, wc = wid & 3, fr = lane & 15, fq = lane >> 4;
    const int K = g.K, nt = K / BK;
    unsigned voffA[2], voffB[2];
#pragma unroll
    for (int i = 0; i < 2; ++i) { int R, C; stage_rc(tid * 16 + i * 8192, R, C); const int Rb = Epi::PERM ? ((R & ~31) + perm32(R & 31)) : R;
        voffA[i] = (unsigned)(R * K + C) * 2u; voffB[i] = (unsigned)(Rb * K + C) * 2u; }
    const size_t kstep = (size_t)(BK * 2);
    const size_t hstep = (size_t)HALF * K * 2;
    const size_t tstep = 2 * hstep;
    const unsigned ldsw = (unsigned)wid * 1024u;
    const int aoff = lds_byte(wr * 64 + fr, fq * 8), boff = lds_byte(wc * 32 + fr, fq * 8);
#define PG8_SA(b, h) (((b) * 2 + (h)) * HTB)
#define PG8_SB(b, h) ((4 + (b) * 2 + (h)) * HTB)
#define PG8_STAGE(bufoff, gbase, voff) do { _Pragma("unroll") for (int _i = 0; _i < 2; ++_i) \
        __builtin_amdgcn_global_load_lds((const unsigned*)((const char*)(gbase) + (voff)[_i]), (PG8_LAS unsigned*)(lds + (bufoff) + ldsw + _i * 8192), 16, 0, 0); } while (0)
#define PG8_LDA(dst, b, h) do { _Pragma("unroll") for (int m = 0; m < 4; ++m) _Pragma("unroll") for (int k = 0; k < 2; ++k) dst[m][k] = *(const PG8_LAS bf16x8*)(lds + PG8_SA(b, h) + aoff + m * 2048 + k * 1024); } while (0)
#define PG8_LDB(dst, b, h) do { _Pragma("unroll") for (int n = 0; n < 2; ++n) _Pragma("unroll") for (int k = 0; k < 2; ++k) dst[n][k] = *(const PG8_LAS bf16x8*)(lds + PG8_SB(b, h) + boff + n * 2048 + k * 1024); } while (0)
#define PG8_MMA(ai, bj, At, Bt) do { __builtin_amdgcn_s_setprio(1); _Pragma("unroll") for (int m = 0; m < 4; ++m) _Pragma("unroll") for (int n = 0; n < 2; ++n) _Pragma("unroll") for (int k = 0; k < 2; ++k) \
        acc[ai][bj][m][n] = __builtin_amdgcn_mfma_f32_16x16x32_bf16(Bt[n][k], At[m][k], acc[ai][bj][m][n], 0, 0, 0); __builtin_amdgcn_s_setprio(0); } while (0)
#define PG8_WAIT_V(n) asm volatile("s_waitcnt vmcnt(" #n ")" ::: "memory")
#define PG8_WAIT_L(n) asm volatile("s_waitcnt lgkmcnt(" #n ")" ::: "memory")
#define PG8_BAR __builtin_amdgcn_s_barrier()
#define PG8_SCHED __builtin_amdgcn_sched_barrier(0)
    Unit cur, nxt; int ui = 0;
    if (!S.next(0, cur)) return;
    f32x4 acc[2][2][4][2];
#pragma unroll
    for (int a = 0; a < 2; ++a)
#pragma unroll
        for (int b = 0; b < 2; ++b)
#pragma unroll
            for (int m = 0; m < 4; ++m)
#pragma unroll
                for (int n = 0; n < 2; ++n) acc[a][b][m][n] = (f32x4){0.f, 0.f, 0.f, 0.f};
    bf16x8 At[4][2], B0[2][2], B1[2][2];
    const char* cA = (const char*)(cur.seg ? g.A2 : g.A) + (size_t)cur.pm * tstep; const char* cB = (const char*)(cur.seg ? g.Bt2 : g.Bt) + (size_t)cur.pn * tstep;
    S.a_ready(cur);
    if constexpr (SP2) {
        PG8_STAGE(PG8_SB(0, 0), cB, voffB); PG8_STAGE(PG8_SB(0, 1), cB + hstep, voffB); PG8_STAGE(PG8_SA(0, 0), cA, voffA); PG8_STAGE(PG8_SA(0, 1), cA + hstep, voffA);
        if (wr == 1) PG8_BAR;
        PG8_WAIT_V(2); PG8_BAR;
        PG8_STAGE(PG8_SB(1, 0), cB + kstep, voffB); PG8_STAGE(PG8_SA(1, 0), cA + kstep, voffA); PG8_STAGE(PG8_SB(1, 1), cB + hstep + kstep, voffB);
        PG8_WAIT_V(6); PG8_BAR;
    } else {
        PG8_STAGE(PG8_SB(0, 0), cB, voffB); PG8_STAGE(PG8_SA(0, 0), cA, voffA); PG8_STAGE(PG8_SB(0, 1), cB + hstep, voffB); PG8_STAGE(PG8_SA(0, 1), cA + hstep, voffA);
        if (wr == 1) PG8_BAR;
        PG8_WAIT_V(4); PG8_BAR;
        PG8_STAGE(PG8_SB(1, 0), cB + kstep, voffB); PG8_STAGE(PG8_SA(1, 0), cA + kstep, voffA); PG8_STAGE(PG8_SB(1, 1), cB + hstep + kstep, voffB);
        PG8_WAIT_V(6); PG8_BAR;
    }
    for (;;) {
        const bool has_next = S.next(ui + 1, nxt);
        const char* nA = has_next ? (const char*)(nxt.seg ? g.A2 : g.A) + (size_t)nxt.pm * tstep : cA; const char* nB = has_next ? (const char*)(nxt.seg ? g.Bt2 : g.Bt) + (size_t)nxt.pn * tstep : cB;
        for (int t = 0; t < nt; t += 2) {
            const bool last = (t == nt - 2);
            const char* a1 = cA + (size_t)(t + 1) * kstep;
            const char* a2 = last ? nA : cA + (size_t)(t + 2) * kstep; const char* b2 = last ? nB : cB + (size_t)(t + 2) * kstep;
            const char* a3 = a2 + kstep; const char* b3 = b2 + kstep;
            if (last && has_next) S.a_ready(nxt);
            if constexpr (SP2) {
            PG8_LDB(B0, 0, 0); PG8_LDB(B1, 0, 1); PG8_SCHED; PG8_LDA(At, 0, 0); PG8_STAGE(PG8_SA(1, 1), a1 + hstep, voffA);
            PG8_WAIT_V(8); PG8_WAIT_L(0); PG8_BAR; PG8_MMA(0, 0, At, B0); PG8_MMA(0, 1, At, B1); PG8_BAR; PG8_SCHED;
            PG8_LDA(At, 0, 1); PG8_STAGE(PG8_SB(0, 0), b2, voffB); PG8_STAGE(PG8_SB(0, 1), b2 + hstep, voffB); PG8_STAGE(PG8_SA(0, 0), a2, voffA);
            PG8_WAIT_V(8); PG8_WAIT_L(0); PG8_BAR; PG8_MMA(1, 0, At, B0); PG8_MMA(1, 1, At, B1); PG8_BAR; PG8_SCHED;
            PG8_LDB(B0, 1, 0); PG8_LDB(B1, 1, 1); PG8_SCHED; PG8_LDA(At, 1, 0); PG8_STAGE(PG8_SA(0, 1), a2 + hstep, voffA);
            PG8_WAIT_V(8); PG8_WAIT_L(0); PG8_BAR; PG8_MMA(0, 0, At, B0); PG8_MMA(0, 1, At, B1); PG8_BAR; PG8_SCHED;
            PG8_LDA(At, 1, 1); PG8_STAGE(PG8_SB(1, 0), b3, voffB); PG8_STAGE(PG8_SB(1, 1), b3 + hstep, voffB); PG8_STAGE(PG8_SA(1, 0), a3, voffA);
            PG8_WAIT_V(8); PG8_WAIT_L(0); PG8_BAR; PG8_MMA(1, 0, At, B0); PG8_MMA(1, 1, At, B1); PG8_BAR; PG8_SCHED;
            } else {
            PG8_LDB(B0, 0, 0); PG8_SCHED; PG8_LDA(At, 0, 0); PG8_STAGE(PG8_SA(1, 1), a1 + hstep, voffA);
            PG8_WAIT_L(8); PG8_BAR; PG8_WAIT_L(0); PG8_MMA(0, 0, At, B0); PG8_BAR; PG8_SCHED;
            PG8_LDB(B1, 0, 1); PG8_STAGE(PG8_SB(0, 0), b2, voffB);
            PG8_BAR; PG8_WAIT_L(0); PG8_MMA(0, 1, At, B1); PG8_BAR;
            PG8_LDA(At, 0, 1); PG8_STAGE(PG8_SA(0, 0), a2, voffA);
            PG8_BAR; PG8_WAIT_L(0); PG8_MMA(1, 0, At, B0); PG8_BAR; PG8_SCHED;
            PG8_STAGE(PG8_SB(0, 1), b2 + hstep, voffB);
            PG8_WAIT_V(6); PG8_BAR; PG8_MMA(1, 1, At, B1); PG8_BAR;
            PG8_LDB(B0, 1, 0); PG8_SCHED; PG8_LDA(At, 1, 0); PG8_STAGE(PG8_SA(0, 1), a2 + hstep, voffA);
            PG8_WAIT_L(8); PG8_BAR; PG8_WAIT_L(0); PG8_MMA(0, 0, At, B0); PG8_BAR; PG8_SCHED;
            PG8_LDB(B1, 1, 1); PG8_STAGE(PG8_SB(1, 0), b3, voffB);
            PG8_BAR; PG8_WAIT_L(0); PG8_MMA(0, 1, At, B1); PG8_BAR;
            PG8_LDA(At, 1, 1); PG8_STAGE(PG8_SA(1, 0), a3, voffA);
            PG8_BAR; PG8_WAIT_L(0); PG8_MMA(1, 0, At, B0); PG8_BAR; PG8_SCHED;
            PG8_STAGE(PG8_SB(1, 1), b3 + hstep, voffB);
            PG8_WAIT_V(6); PG8_BAR; PG8_MMA(1, 1, At, B1); PG8_BAR;
            }
        }
        if constexpr (ALIGN_EPI) { if (wr == 0) PG8_BAR; }
        if constexpr (!Epi::AFTER_DRAIN) { E(acc, cur, wr, wc, fr, fq);
#ifdef EXP_EPI2
            if constexpr (Epi::IDEMPOTENT) { asm volatile("" ::: "memory"); E(acc, cur, wr, wc, fr, fq); }
#endif
            S.done(cur); }
        if (!has_next) break;
#pragma unroll
        for (int a = 0; a < 2; ++a)
#pragma unroll
            for (int b = 0; b < 2; ++b)
#pragma unroll
                for (int m = 0; m < 4; ++m)
#pragma unroll
                    for (int n = 0; n < 2; ++n) acc[a][b][m][n] = (f32x4){0.f, 0.f, 0.f, 0.f};
        cur = nxt; cA = nA; cB = nB; ++ui;
        if constexpr (ALIGN_EPI) { if (wr == 1) PG8_BAR; }
    }
    PG8_WAIT_V(0);
    if constexpr (!ALIGN_EPI) { if (wr == 0) PG8_BAR; }
    PG8_BAR;
    if constexpr (Epi::AFTER_DRAIN) { E.fused(acc, cur, wr, wc, fr, fq, lds, wid, lane); S.done(cur); }
#undef PG8_SA
#undef PG8_SB
#undef PG8_STAGE
#undef PG8_LDA
#undef PG8_LDB
#undef PG8_MMA
#undef PG8_WAIT_V
#undef PG8_WAIT_L
#undef PG8_BAR
#undef PG8_SCHED
}
}
constexpr size_t MiB = 1u << 20;
constexpr size_t WS_SS = 0;
constexpr size_t WS_XTAIL = 1 * MiB;
constexpr size_t WS_W = 2 * MiB;
constexpr size_t W_LAYER = 39 * MiB + MiB / 2, W_A = 17 * MiB, W_B = 19 * MiB, W_O = 21 * MiB, W_GU = 23 * MiB, W_D = 34 * MiB;
constexpr size_t WS_XB = 81 * MiB;
constexpr size_t WS_GK = WS_XB + 32 * MiB + MiB / 2;
constexpr size_t WS_AIN = WS_GK + 32 * MiB + MiB / 2;
constexpr size_t WS_BIN = WS_AIN + 32 * MiB + MiB / 2;
constexpr size_t WS_OB = WS_BIN + 32 * MiB + MiB / 2;
constexpr size_t WS_PROJ = WS_OB + 32 * MiB + MiB / 2;
constexpr size_t WS_G0 = WS_PROJ + 260 * MiB;
constexpr size_t WS_END = WS_G0 + 1 * MiB;
constexpr size_t O_YP = 0, O_YS = 16777216, O_PCONV = 16908288, O_PGLA = 16941056, O_SCONV = 19038208, O_SGLA = 19562496;

struct Args {
    const float *x_prompt, *x_sample, *state_conv, *state_gla, *meta, *w_in, *conv_w, *w_gk2, *b_gk2, *gla_gain, *w_a, *w_b, *w_o, *norm_mix, *norm_ffn, *w_gu, *w_down, *final_norm;
    float* out; unsigned char* ws;
};

__device__ __forceinline__ float wave_sum(float v) {
#pragma unroll
    for (int o = 1; o < 64; o <<= 1) v += __shfl_xor(v, o);
    return v;
}

__device__ __forceinline__ void p0_item(const float* W, int ldw, int srccol, const float* rowscale, float cscale, const float* wgk2  , int jcol,
                                        bf16_t* WT, int K, int nrow0, int k0, LAS float* scr, int lane) {
    const int nn = lane & 31;
    if (wgk2 == nullptr) {
        const int kr = lane >> 3, c4 = (lane & 7) * 4;
        f32x4 v[8]; float rs[8];
#pragma unroll
        for (int j = 0; j < 8; ++j) { const int kk = 8 * j + kr; v[j] = __builtin_nontemporal_load((const f32x4*)(W + (size_t)(k0 + kk) * ldw + srccol + c4)); rs[j] = rowscale ? rowscale[k0 + kk] * cscale : cscale; }
#pragma unroll
        for (int j = 0; j < 8; ++j) { const int kk = 8 * j + kr; LAS float* sp = scr + kk * 33 + c4; sp[0] = v[j][0] * rs[j]; sp[1] = v[j][1] * rs[j]; sp[2] = v[j][2] * rs[j]; sp[3] = v[j][3] * rs[j]; }
    } else {
        float g2[16];
#pragma unroll
        for (int r = 0; r < 16; ++r) g2[r] = wgk2[r * 512 + jcol + nn];
#pragma unroll 4
        for (int i = 0; i < 32; ++i) { const int kk = 2 * i + (lane >> 5); const float* zr = W + (size_t)(k0 + kk) * ldw + 6144; float v = 0.f;
#pragma unroll
            for (int r = 0; r < 16; ++r) v += zr[r] * g2[r];
            scr[kk * 33 + nn] = v * rowscale[k0 + kk]; }
    }
    asm volatile("s_waitcnt lgkmcnt(0)" ::: "memory");
    const int c = lane & 7;
#pragma unroll
    for (int j = 0; j < 4; ++j) { const int n = (lane >> 3) + 8 * j; const LAS float* s = scr + (8 * c) * 33 + n;
        u32x4 o; o.x = pk_bf16(s[0 * 33], s[1 * 33]); o.y = pk_bf16(s[2 * 33], s[3 * 33]); o.z = pk_bf16(s[4 * 33], s[5 * 33]); o.w = pk_bf16(s[6 * 33], s[7 * 33]);
        *(u32x4*)(WT + (size_t)(nrow0 + n) * K + k0 + 8 * c) = o; }
    asm volatile("s_waitcnt lgkmcnt(0)" ::: "memory");
}

typedef const __attribute__((address_space(4))) unsigned long long* KP;
__device__ __forceinline__ void p0_prologue(KP kp, LAS unsigned char* lds) {
    const int tid = ltid(), lane = tid & 63, wave = tid >> 6;
    LAS float* scr = (LAS float*)(lds + wave * 16384);
    const int gw = blockIdx.x * 8 + wave, NGW = gridDim.x * 8;
    constexpr int I_1 = 16 * 272, I_S = 16 * 32, I_GU = 16 * 176, I_D = 44 * 32, I_L = I_1 + 3 * I_S + I_GU + I_D;
    for (int it = gw; it < 2 * I_L; it += NGW) {
        const int l = it / I_L; int r = it % I_L;
        unsigned char* wl = GP(unsigned char, 19) + WS_W + (size_t)l * W_LAYER;
        if (r < I_1) { const int kb = r / 272, nb = r % 272, n0 = nb * 32; const float* W = GP(const float, 5) + (size_t)l * 1024 * 8208; const float* nm = GP(const float, 13) + l * 1024;
            if (n0 < 8192) { const int src = n0 < 6144 ? n0 : n0 + 16; const float cs = (n0 >= C_Q && n0 < C_K) ? 0.08838834764831845f : 1.f;
                p0_item(W, 8208, src, nm, cs, nullptr, 0, (bf16_t*)wl, 1024, n0, kb * 64, scr, lane); }
            else p0_item(W, 8208, 0, nm, 1.f, GP(const float, 7) + (size_t)l * 16 * 512, n0 - 8192, (bf16_t*)wl, 1024, n0, kb * 64, scr, lane);
            continue; }
        r -= I_1;
        if (r < 3 * I_S) { const int which = r / I_S; r %= I_S; const int kb = r / 32, nb = r % 32;
            const float* W = GP(const float, 10 + which) + (size_t)l * 1024 * 1024;
            p0_item(W, 1024, nb * 32, nullptr, 1.f, nullptr, 0, (bf16_t*)(wl + W_A + (size_t)which * 2 * MiB), 1024, nb * 32, kb * 64, scr, lane); continue; }
        r -= 3 * I_S;
        if (r < I_GU) { const int kb = r / 176, nb = r % 176, n0 = nb * 32;
            const int pn = n0 >> 8, bj = (n0 >> 7) & 1, j = n0 & 127;
            p0_item(GP(const float, 15) + (size_t)l * 1024 * 5632, 5632, bj * DFF + 128 * pn + j, GP(const float, 14) + l * 1024, 1.f, nullptr, 0, (bf16_t*)(wl + W_GU), 1024, n0, kb * 64, scr, lane); continue; }
        r -= I_GU;
        { const int kb = r / 32, nb = r % 32; p0_item(GP(const float, 16) + (size_t)l * DFF * 1024, 1024, nb * 32, nullptr, 1.f, nullptr, 0, (bf16_t*)(wl + W_D), DFF, nb * 32, kb * 64, scr, lane); }
    }
    float* ss = (float*)(GP(unsigned char, 19) + WS_SS); bf16_t* xb = (bf16_t*)(GP(unsigned char, 19) + WS_XB);
    for (int row0 = gw; row0 < M_ROWS; row0 += 2 * NGW) { f32x4 v[2][4]; int rows[2];
#pragma unroll
        for (int u = 0; u < 2; ++u) { const int row = row0 + u * NGW; rows[u] = row < M_ROWS ? row : -1;
            if (rows[u] >= 0) { const float* src = row < NREAL ? GP(const float, 0) + (size_t)row * DM : row < NPROMPT ? GP(const float, 4) + (size_t)((row - NREAL) & 15) * DM : GP(const float, 1) + (size_t)(row - NPROMPT) * DM;
#pragma unroll
                for (int j = 0; j < 4; ++j) v[u][j] = __builtin_nontemporal_load((const f32x4*)src + lane + 64 * j); } }
#pragma unroll
        for (int u = 0; u < 2; ++u) if (rows[u] >= 0) { float s = 0.f;
#pragma unroll
            for (int j = 0; j < 4; ++j) { u32x2 w; w.x = pk_bf16(v[u][j][0], v[u][j][1]); w.y = pk_bf16(v[u][j][2], v[u][j][3]); *((u32x2*)(xb + (size_t)rows[u] * DM) + lane + 64 * j) = w;
                const float r0 = bflo(w.x), r1 = bfhi(w.x), r2 = bflo(w.y), r3 = bfhi(w.y); s += (r0 * r0 + r1 * r1) + (r2 * r2 + r3 * r3); }
            s = wave_sum(s); if (lane == 0) ss[rows[u]] = s; } }
    { const int gt = blockIdx.x * 512 + tid, NT = gridDim.x * 512;
      for (int i = gt; i < 4 * M_ROWS + 8 * M_ROWS; i += NT) ss[M_ROWS + i] = 0.f; }
}

constexpr int QS = 136, VS_ = 72;
#ifdef DBG_GLA_DBLBAR
#define GLA_SYNC() do { __syncthreads(); asm volatile("s_waitcnt vmcnt(0) lgkmcnt(0)" ::: "memory"); __syncthreads(); } while (0)
#else
#define GLA_SYNC() __syncthreads()
#endif
__device__ __forceinline__ void gla_prompt_item(LAS unsigned char* lds, int item, const bf16_t* proj, const float* gkb, bf16_t* obuf, float* ossq, float* pgla, bool do_atomic = true) {
    const int tid = ltid(), lane = tid & 63, w = __builtin_amdgcn_readfirstlane(tid >> 6), fr = lane & 15, fq = lane >> 4;
    const int b = item >> 4, h = (item >> 2) & 3, vs = item & 3;
    LAS bf16_t* QT = (LAS bf16_t*)lds;
    LAS bf16_t* KT = (LAS bf16_t*)(lds + 17408);
    LAS float*  GK = (LAS float*)(lds + 34816);
    LAS bf16_t* KH = (LAS bf16_t*)(lds + 67584);
    LAS bf16_t* VT = (LAS bf16_t*)(lds + 86016);
    LAS bf16_t* AM = (LAS bf16_t*)(lds + 95232);
    LAS bf16_t* ST = (LAS bf16_t*)(lds + 104448);
    LAS float*  PT = (LAS float*)(lds + 121856);
    LAS float*  DC = (LAS float*)(lds + 125952);
    GLA_SYNC();
    for (int i = tid; i < 64 * QS / 2; i += 512) ((LAS unsigned*)ST)[i] = 0u;
    f32x4 sacc[4];
#pragma unroll
    for (int x = 0; x < 4; ++x) sacc[x] = (f32x4){0.f, 0.f, 0.f, 0.f};
    u32x4 rq[2], rk[2], rv, rg[4];
    u32x2 ow0 = {0u, 0u}, ow1 = {0u, 0u}; float osq = 0.f; int orow = -1;
    const int qt0 = tid >> 4, qc = tid & 15, vt = tid >> 3, vc = tid & 7, gt0 = tid >> 5, gc = tid & 31;
#define GLA_FLUSH() do { if (orow >= 0) { bf16_t* op_ = obuf + (size_t)orow * DM + h * 256 + vs * 64 + 32 * (w & 1) + 4 * fq; *(u32x2*)op_ = ow0; *(u32x2*)(op_ + 16) = ow1; \
        float s_ = osq; s_ += __shfl_xor(s_, 16); s_ += __shfl_xor(s_, 32); if (fq == 0 && do_atomic) __hip_atomic_fetch_add((__attribute__((address_space(1))) float*)(ossq + (size_t)orow * 4 + h), s_, __ATOMIC_RELAXED, __HIP_MEMORY_SCOPE_AGENT); } \
        else { float s_ = osq; s_ += __shfl_xor(s_, 16); s_ += __shfl_xor(s_, 32); (void)s_; } } while (0)
#define GLA_ROW(c, t) ((c) == 0 ? NREAL + b * 16 + (t) : b * 2048 + ((c) - 1) * 64 + (t))
#define GLA_PREFETCH(c) do { const int nv = (c) == 0 ? 16 : 64; const u32x4 z4 = {0u, 0u, 0u, 0u}; \
        _Pragma("unroll") for (int i = 0; i < 2; ++i) { const int t = qt0 + 32 * i; const bf16_t* p = proj + (size_t)GLA_ROW(c, t) * NPROJ + h * 128 + qc * 8; \
            rq[i] = t < nv ? *(const u32x4*)(p + C_Q) : z4; rk[i] = t < nv ? *(const u32x4*)(p + C_K) : z4; } \
        rv = vt < nv ? *(const u32x4*)(proj + (size_t)GLA_ROW(c, vt) * NPROJ + C_V + h * 256 + vs * 64 + vc * 8) : z4; \
        _Pragma("unroll") for (int i = 0; i < 4; ++i) { const int t = gt0 + 16 * i; rg[i] = t < nv ? *(const u32x4*)(gkb + (size_t)GLA_ROW(c, t) * 512 + h * 128 + gc * 4) : z4; } } while (0)
#ifndef DBG_GLA_SYNCLOAD
    GLA_PREFETCH(0);
#endif
    for (int c = 0; c < 33; ++c) {
#ifdef DBG_GLA_SYNCLOAD
        GLA_PREFETCH(c);
#endif
#pragma unroll
        for (int i = 0; i < 2; ++i) { const int t = qt0 + 32 * i; *(LAS u32x4*)(QT + t * QS + qc * 8) = rq[i]; *(LAS u32x4*)(KT + t * QS + qc * 8) = rk[i]; }
#pragma unroll
        for (int i = 0; i < 4; ++i) { const int t = gt0 + 16 * i; *(LAS u32x4*)(GK + t * 128 + gc * 4) = rg[i]; }
        { LAS bf16_t* vp = VT + (vc * 8) * VS_ + vt;
          vp[0 * VS_] = (bf16_t)(rv.x & 0xffffu); vp[1 * VS_] = (bf16_t)(rv.x >> 16); vp[2 * VS_] = (bf16_t)(rv.y & 0xffffu); vp[3 * VS_] = (bf16_t)(rv.y >> 16);
          vp[4 * VS_] = (bf16_t)(rv.z & 0xffffu); vp[5 * VS_] = (bf16_t)(rv.z >> 16); vp[6 * VS_] = (bf16_t)(rv.w & 0xffffu); vp[7 * VS_] = (bf16_t)(rv.w >> 16); }
        GLA_FLUSH();
        GLA_SYNC();
#ifndef DBG_GLA_SYNCLOAD
        if (c + 1 < 33) GLA_PREFETCH(c + 1);
#endif
        { typedef float f32x2_t __attribute__((ext_vector_type(2)));
          const int d2 = (tid & 63) * 2, part = w, t0 = part * 8;
          float c0[8], c1[8]; float r0 = 0.f, r1 = 0.f;
#pragma unroll
          for (int i = 0; i < 8; ++i) { const f32x2_t g = *(const LAS f32x2_t*)(GK + (t0 + i) * 128 + d2); r0 += g.x * 1.44269504f; r1 += g.y * 1.44269504f; c0[i] = r0; c1[i] = r1; }
          *(LAS f32x2_t*)(PT + part * 128 + d2) = (f32x2_t){r0, r1};
          GLA_SYNC();
          float o0 = 0.f, o1 = 0.f, bl0 = 0.f, bl1 = 0.f;
#pragma unroll
          for (int p = 0; p < 8; ++p) { const f32x2_t v = *(const LAS f32x2_t*)(PT + p * 128 + d2); if (p < part) { o0 += v.x; o1 += v.y; } bl0 += v.x; bl1 += v.y; }
          const float E0 = __builtin_amdgcn_exp2f(bl0), E1 = __builtin_amdgcn_exp2f(bl1);
          unsigned kh0[4], kh1[4];
#pragma unroll
          for (int i = 0; i < 8; i += 2) {
              LAS unsigned* qp0 = (LAS unsigned*)(QT + (t0 + i) * QS + d2); LAS unsigned* qp1 = (LAS unsigned*)(QT + (t0 + i + 1) * QS + d2);
              LAS unsigned* kp0 = (LAS unsigned*)(KT + (t0 + i) * QS + d2); LAS unsigned* kp1 = (LAS unsigned*)(KT + (t0 + i + 1) * QS + d2);
              const unsigned qa = *qp0, qb = *qp1, ka = *kp0, kb = *kp1;
              const float b00 = o0 + c0[i], b01 = o1 + c1[i], b10 = o0 + c0[i + 1], b11 = o1 + c1[i + 1];
              const float n00 = bflo(ka) * __builtin_amdgcn_exp2f(-b00), n01 = bfhi(ka) * __builtin_amdgcn_exp2f(-b01), n10 = bflo(kb) * __builtin_amdgcn_exp2f(-b10), n11 = bfhi(kb) * __builtin_amdgcn_exp2f(-b11);
              *qp0 = pk_bf16(bflo(qa) * __builtin_amdgcn_exp2f(b00), bfhi(qa) * __builtin_amdgcn_exp2f(b01)); *qp1 = pk_bf16(bflo(qb) * __builtin_amdgcn_exp2f(b10), bfhi(qb) * __builtin_amdgcn_exp2f(b11));
              *kp0 = pk_bf16(n00, n01); *kp1 = pk_bf16(n10, n11);
              kh0[i >> 1] = pk_bf16(n00 * E0, n10 * E0); kh1[i >> 1] = pk_bf16(n01 * E1, n11 * E1); }
          *(LAS u32x4*)(KH + d2 * VS_ + t0) = (u32x4){kh0[0], kh0[1], kh0[2], kh0[3]}; *(LAS u32x4*)(KH + (d2 + 1) * VS_ + t0) = (u32x4){kh1[0], kh1[1], kh1[2], kh1[3]};
          if (part == 0) { DC[d2] = E0; DC[d2 + 1] = E1; } }
        GLA_SYNC();
        { const int ti = w >> 1;
#pragma unroll
          for (int jj = 0; jj < 2; ++jj) { const int sj = (w & 1) * 2 + jj; f32x4 acc = {0.f, 0.f, 0.f, 0.f};
              if (sj <= ti) {
#pragma unroll
                  for (int kk = 0; kk < 4; ++kk) { const bf16x8 ao = *(const LAS bf16x8*)(KT + (16 * sj + fr) * QS + 32 * kk + 8 * fq), bo = *(const LAS bf16x8*)(QT + (16 * ti + fr) * QS + 32 * kk + 8 * fq);
                      acc = __builtin_amdgcn_mfma_f32_16x16x32_bf16(ao, bo, acc, 0, 0, 0); }
                  if (sj == ti) {
#pragma unroll
                      for (int e = 0; e < 4; ++e) if (4 * fq + e > fr) acc[e] = 0.f; }
              }
              u32x2 wv; wv.x = pk_bf16(acc[0], acc[1]); wv.y = pk_bf16(acc[2], acc[3]);
              *(LAS u32x2*)(AM + (16 * ti + fr) * VS_ + 16 * sj + 4 * fq) = wv; } }
        GLA_SYNC();
        { const int ti = w >> 1; const int t = 16 * ti + fr; const int nv = c == 0 ? 16 : 64; float sq = 0.f;
          const int row = GLA_ROW(c, t);
#pragma unroll
          for (int jj = 0; jj < 2; ++jj) { const int jv = (w & 1) * 2 + jj; f32x4 acc = {0.f, 0.f, 0.f, 0.f};
#pragma unroll
              for (int kk = 0; kk < 2; ++kk) { const bf16x8 ao = *(const LAS bf16x8*)(VT + (16 * jv + fr) * VS_ + 32 * kk + 8 * fq), bo = *(const LAS bf16x8*)(AM + (16 * ti + fr) * VS_ + 32 * kk + 8 * fq);
                  acc = __builtin_amdgcn_mfma_f32_16x16x32_bf16(ao, bo, acc, 0, 0, 0); }
#pragma unroll
              for (int kk = 0; kk < 4; ++kk) { const bf16x8 ao = *(const LAS bf16x8*)(ST + (16 * jv + fr) * QS + 32 * kk + 8 * fq), bo = *(const LAS bf16x8*)(QT + (16 * ti + fr) * QS + 32 * kk + 8 * fq);
                  acc = __builtin_amdgcn_mfma_f32_16x16x32_bf16(ao, bo, acc, 0, 0, 0); }
              sq += (acc[0] * acc[0] + acc[1] * acc[1]) + (acc[2] * acc[2] + acc[3] * acc[3]);
              { u32x2 wv; wv.x = pk_bf16(acc[0], acc[1]); wv.y = pk_bf16(acc[2], acc[3]); if (jj == 0) ow0 = wv; else ow1 = wv; } }
          osq = sq; orow = t < nv ? row : -1; }
        { const int jv = w >> 1;
#pragma unroll
          for (int x = 0; x < 4; ++x) { const int jd = (w & 1) * 4 + x; const float dcy = DC[16 * jd + fr]; sacc[x] = sacc[x] * dcy;
#pragma unroll
              for (int kk = 0; kk < 2; ++kk) { const bf16x8 ao = *(const LAS bf16x8*)(VT + (16 * jv + fr) * VS_ + 32 * kk + 8 * fq), bo = *(const LAS bf16x8*)(KH + (16 * jd + fr) * VS_ + 32 * kk + 8 * fq);
                  sacc[x] = __builtin_amdgcn_mfma_f32_16x16x32_bf16(ao, bo, sacc[x], 0, 0, 0); } } }
        GLA_SYNC();
        { const int jv = w >> 1;
#pragma unroll
          for (int x = 0; x < 4; ++x) { const int jd = (w & 1) * 4 + x;
#pragma unroll
              for (int e = 0; e < 4; ++e) ST[(16 * jv + 4 * fq + e) * QS + 16 * jd + fr] = f2bf(sacc[x][e]); } }
    }
    GLA_FLUSH();
    { const int jv = w >> 1;
#pragma unroll
      for (int x = 0; x < 4; ++x) { const int d = 16 * ((w & 1) * 4 + x) + fr; *(f32x4*)(pgla + ((size_t)((b * 4 + h) * 128 + d)) * 256 + vs * 64 + 16 * jv + 4 * fq) = sacc[x]; } }
#undef GLA_ROW
#undef GLA_FLUSH
#undef GLA_PREFETCH
}

__device__ __forceinline__ void unpack8(const u32x4 w, float (&f)[8]) { f[0] = bflo(w.x); f[1] = bfhi(w.x); f[2] = bflo(w.y); f[3] = bfhi(w.y); f[4] = bflo(w.z); f[5] = bfhi(w.z); f[6] = bflo(w.w); f[7] = bfhi(w.w); }
__device__ __forceinline__ void gla_sample_item(LAS unsigned char* lds, int item, int layer, const bf16_t* proj, const float* gkb, const float* sgla_in, float* sgla_out, const float* gain, bf16_t* b_in) {
    const int tid = ltid(), lane = tid & 63, w = tid >> 6, s = item >> 2, h = item & 3, row = NPROMPT + s, c4 = lane * 4;
    LAS float* red = (LAS float*)lds;
    LAS float* wsum = red + 8 * 256;
    const bf16_t* pr = proj + (size_t)row * NPROJ;
    const u32x2 vw = *(const u32x2*)(pr + C_V + h * 256 + c4);
    const f32x4 v4 = {bflo(vw.x), bfhi(vw.x), bflo(vw.y), bfhi(vw.y)};
    const size_t sbase = ((size_t)((layer * 128 + s) * 4 + h) * 128) * 256;
    f32x4 oacc = {0.f, 0.f, 0.f, 0.f};
    __syncthreads();
    { f32x4 sv[16]; float qd[16], kd[16], eg[16];
#pragma unroll
      for (int i = 0; i < 16; ++i) { const int dk = w * 16 + i; sv[i] = __builtin_nontemporal_load((const f32x4*)(sgla_in + sbase + (size_t)dk * 256 + c4)); }
      const u32x4 q0 = *(const u32x4*)(pr + C_Q + h * 128 + w * 16), q1 = *(const u32x4*)(pr + C_Q + h * 128 + w * 16 + 8);
      const u32x4 k0 = *(const u32x4*)(pr + C_K + h * 128 + w * 16), k1 = *(const u32x4*)(pr + C_K + h * 128 + w * 16 + 8);
      { float t8[8]; unpack8(q0, t8);
#pragma unroll
        for (int e = 0; e < 8; ++e) qd[e] = t8[e];
        unpack8(q1, t8);
#pragma unroll
        for (int e = 0; e < 8; ++e) qd[8 + e] = t8[e];
        unpack8(k0, t8);
#pragma unroll
        for (int e = 0; e < 8; ++e) kd[e] = t8[e];
        unpack8(k1, t8);
#pragma unroll
        for (int e = 0; e < 8; ++e) kd[8 + e] = t8[e]; }
#pragma unroll
      for (int j = 0; j < 4; ++j) { const f32x4 g4 = *(const f32x4*)(gkb + (size_t)row * 512 + h * 128 + w * 16 + 4 * j); eg[4 * j] = g4[0]; eg[4 * j + 1] = g4[1]; eg[4 * j + 2] = g4[2]; eg[4 * j + 3] = g4[3]; }
#pragma unroll
      for (int i = 0; i < 16; ++i) { const int dk = w * 16 + i; const f32x4 sn = sv[i] * __expf(eg[i]) + v4 * kd[i];
          __builtin_nontemporal_store(sn, (f32x4*)(sgla_out + sbase + (size_t)dk * 256 + c4)); oacc += sn * qd[i]; } }
    *(LAS f32x4*)(red + w * 256 + c4) = oacc;
    __syncthreads();
    float o = 0.f;
    if (tid < 256) {
#pragma unroll
        for (int g = 0; g < 8; ++g) o += red[g * 256 + tid];
        const float sq = wave_sum(o * o); if (lane == 0) wsum[w] = sq; }
    __syncthreads();
    if (tid < 256) { const float tot = (wsum[0] + wsum[1]) + (wsum[2] + wsum[3]); const float rs = rsqrtf(tot * (1.f / 256.f) + EPS);
        const float og = bf2f(pr[C_OG + h * 256 + tid]);
        b_in[(size_t)row * DM + h * 256 + tid] = f2bf(o * rs * gain[tid] * silu(og)); }
}

__device__ __forceinline__ void conv_rows(int it, int layer, const bf16_t* proj, const float* conv_w, const float* state_conv, bf16_t* a_in, float* pconv, float* sconv) {
    const int tid = ltid(), row = it * 4 + (tid >> 7), c8 = (tid & 127) * 8;
    float u0[8], u1[8], u2[8], gB[8], cw0[8], cw1[8], cw2[8], a[8], b_[8];
    const bf16_t* pr = proj + (size_t)row * NPROJ + c8;
    unpack8(*(const u32x4*)(pr + C_GC), a); unpack8(*(const u32x4*)(pr + C_H), b_);
#pragma unroll
    for (int e = 0; e < 8; ++e) u0[e] = a[e] * b_[e];
    unpack8(*(const u32x4*)(pr + C_GB), gB);
    int r1 = -1, r2 = -1;
    if (row < NREAL) { const int bb = row >> 11, t = row & 2047; r1 = t >= 1 ? row - 1 : NREAL + bb * 16 + 15; r2 = t >= 2 ? row - 2 : NREAL + bb * 16 + 14 + t; }
    else if (row < NPROMPT) { const int i = (row - NREAL) & 15; r1 = i >= 1 ? row - 1 : -1; r2 = i >= 2 ? row - 2 : -1; }
    if (row >= NPROMPT) { const int s = row - NPROMPT; const float* st = state_conv + ((size_t)(layer * 128 + s) * 2) * 1024 + c8;
#pragma unroll
        for (int e = 0; e < 8; ++e) { u2[e] = st[e]; u1[e] = st[1024 + e]; }
        float* so = sconv + ((size_t)(layer * 128 + s) * 2) * 1024 + c8;
        *(f32x4*)so = (f32x4){u1[0], u1[1], u1[2], u1[3]}; *(f32x4*)(so + 4) = (f32x4){u1[4], u1[5], u1[6], u1[7]};
        *(f32x4*)(so + 1024) = (f32x4){u0[0], u0[1], u0[2], u0[3]}; *(f32x4*)(so + 1028) = (f32x4){u0[4], u0[5], u0[6], u0[7]};
    } else {
        if (r1 >= 0) { const bf16_t* p1 = proj + (size_t)r1 * NPROJ + c8; unpack8(*(const u32x4*)(p1 + C_GC), a); unpack8(*(const u32x4*)(p1 + C_H), b_);
#pragma unroll
            for (int e = 0; e < 8; ++e) u1[e] = a[e] * b_[e]; }
        else {
#pragma unroll
            for (int e = 0; e < 8; ++e) u1[e] = 0.f; }
        if (r2 >= 0) { const bf16_t* p2 = proj + (size_t)r2 * NPROJ + c8; unpack8(*(const u32x4*)(p2 + C_GC), a); unpack8(*(const u32x4*)(p2 + C_H), b_);
#pragma unroll
            for (int e = 0; e < 8; ++e) u2[e] = a[e] * b_[e]; }
        else {
#pragma unroll
            for (int e = 0; e < 8; ++e) u2[e] = 0.f; }
        if (row < NREAL && (row & 2047) >= 2046) { float* po = pconv + ((size_t)((layer * 8 + (row >> 11)) * 2 + ((row & 2047) - 2046))) * 1024 + c8;
            *(f32x4*)po = (f32x4){u0[0], u0[1], u0[2], u0[3]}; *(f32x4*)(po + 4) = (f32x4){u0[4], u0[5], u0[6], u0[7]}; }
    }
    const float* cw = conv_w + (size_t)layer * 3 * 1024 + c8;
#pragma unroll
    for (int e = 0; e < 8; ++e) { cw0[e] = cw[e]; cw1[e] = cw[1024 + e]; cw2[e] = cw[2048 + e]; }
    float y[8];
#pragma unroll
    for (int e = 0; e < 8; ++e) y[e] = gB[e] * (cw0[e] * u2[e] + cw1[e] * u1[e] + cw2[e] * u0[e]);
    u32x4 wv; wv.x = pk_bf16(y[0], y[1]); wv.y = pk_bf16(y[2], y[3]); wv.z = pk_bf16(y[4], y[5]); wv.w = pk_bf16(y[6], y[7]);
    *(u32x4*)(a_in + (size_t)row * DM + c8) = wv;
}

__device__ __forceinline__ void conv_prompt2(int it0, int stride, int it_end, int layer, const bf16_t* proj, const float* conv_w, bf16_t* a_in, float* pconv) {
    const int tid = ltid(), c8 = (tid & 127) * 8; u32x4 gc[2][3], hh[2][3], gb[2]; int rows[2]; bool v1[2], v2[2];
#pragma unroll
    for (int u = 0; u < 2; ++u) { const int it = it0 + u * stride; rows[u] = it < it_end ? it * 4 + (tid >> 7) : -1; v1[u] = false; v2[u] = false;
        if (rows[u] >= 0) { const int row = rows[u]; int r1, r2;
            if (row < NREAL) { const int bb = row >> 11, t = row & 2047; r1 = t >= 1 ? row - 1 : NREAL + bb * 16 + 15; r2 = t >= 2 ? row - 2 : NREAL + bb * 16 + 14 + t; }
            else { const int i = (row - NREAL) & 15; r1 = i >= 1 ? row - 1 : -1; r2 = i >= 2 ? row - 2 : -1; }
            v1[u] = r1 >= 0; v2[u] = r2 >= 0; if (r1 < 0) r1 = row; if (r2 < 0) r2 = row;
            const bf16_t* p0 = proj + (size_t)row * NPROJ + c8; const bf16_t* p1 = proj + (size_t)r1 * NPROJ + c8; const bf16_t* p2 = proj + (size_t)r2 * NPROJ + c8;
            gc[u][0] = __builtin_nontemporal_load((const u32x4*)(p0 + C_GC)); hh[u][0] = __builtin_nontemporal_load((const u32x4*)(p0 + C_H)); gb[u] = __builtin_nontemporal_load((const u32x4*)(p0 + C_GB));
            gc[u][1] = __builtin_nontemporal_load((const u32x4*)(p1 + C_GC)); hh[u][1] = __builtin_nontemporal_load((const u32x4*)(p1 + C_H)); gc[u][2] = __builtin_nontemporal_load((const u32x4*)(p2 + C_GC)); hh[u][2] = __builtin_nontemporal_load((const u32x4*)(p2 + C_H)); } }
    const float* cw = conv_w + (size_t)layer * 3 * 1024 + c8; float cw0[8], cw1[8], cw2[8];
#pragma unroll
    for (int e = 0; e < 8; ++e) { cw0[e] = cw[e]; cw1[e] = cw[1024 + e]; cw2[e] = cw[2048 + e]; }
#pragma unroll
    for (int u = 0; u < 2; ++u) if (rows[u] >= 0) { const int row = rows[u]; float a[8], b_[8], u0[8], u1[8], u2[8], gB[8], y[8];
        unpack8(gc[u][0], a); unpack8(hh[u][0], b_);
#pragma unroll
        for (int e = 0; e < 8; ++e) u0[e] = a[e] * b_[e];
        unpack8(gc[u][1], a); unpack8(hh[u][1], b_);
#pragma unroll
        for (int e = 0; e < 8; ++e) u1[e] = v1[u] ? a[e] * b_[e] : 0.f;
        unpack8(gc[u][2], a); unpack8(hh[u][2], b_);
#pragma unroll
        for (int e = 0; e < 8; ++e) u2[e] = v2[u] ? a[e] * b_[e] : 0.f;
        unpack8(gb[u], gB);
        if (row < NREAL && (row & 2047) >= 2046) { float* po = pconv + ((size_t)((layer * 8 + (row >> 11)) * 2 + ((row & 2047) - 2046))) * 1024 + c8;
            *(f32x4*)po = (f32x4){u0[0], u0[1], u0[2], u0[3]}; *(f32x4*)(po + 4) = (f32x4){u0[4], u0[5], u0[6], u0[7]}; }
#pragma unroll
        for (int e = 0; e < 8; ++e) y[e] = gB[e] * (cw0[e] * u2[e] + cw1[e] * u1[e] + cw2[e] * u0[e]);
        u32x4 wv; wv.x = pk_bf16(y[0], y[1]); wv.y = pk_bf16(y[2], y[3]); wv.z = pk_bf16(y[4], y[5]); wv.w = pk_bf16(y[6], y[7]);
        *(u32x4*)(a_in + (size_t)row * DM + c8) = wv; }
}

__device__ __forceinline__ void prep_rows4(int it0, int stride, const bf16_t* proj, const bf16_t* obuf, const float* ossq, const float* gain, bf16_t* b_in) {
    const int tid = ltid(), c8 = (tid & 127) * 8; u32x4 ov[4], gv[4]; float sv[4]; int rows[4];
#pragma unroll
    for (int u = 0; u < 4; ++u) { const int it = it0 + u * stride; rows[u] = it < NPROMPT / 4 ? it * 4 + (tid >> 7) : -1;
        if (rows[u] >= 0) { ov[u] = __builtin_nontemporal_load((const u32x4*)(obuf + (size_t)rows[u] * DM + c8)); gv[u] = __builtin_nontemporal_load((const u32x4*)(proj + (size_t)rows[u] * NPROJ + C_OG + c8)); sv[u] = ossq[(size_t)rows[u] * 4 + (c8 >> 8)]; } }
    const float* gn = gain + (c8 & 255); const f32x4 g0 = *(const f32x4*)gn, g1 = *(const f32x4*)(gn + 4);
#pragma unroll
    for (int u = 0; u < 4; ++u) if (rows[u] >= 0) { float o[8], g[8]; unpack8(ov[u], o); unpack8(gv[u], g); const float rs = rsqrtf(sv[u] * (1.f / 256.f) + EPS);
        float y[8];
#pragma unroll
        for (int e = 0; e < 8; ++e) y[e] = o[e] * rs * (e < 4 ? g0[e & 3] : g1[e & 3]) * silu(g[e]);
        u32x4 wv; wv.x = pk_bf16(y[0], y[1]); wv.y = pk_bf16(y[2], y[3]); wv.z = pk_bf16(y[4], y[5]); wv.w = pk_bf16(y[6], y[7]);
        *(u32x4*)(b_in + (size_t)rows[u] * DM + c8) = wv; }
}

template <bool ADD> struct TailGate {
    const bf16_t* gate; bf16_t* mb;
    __device__ __forceinline__ void operator()(const f32x4 a, int row, int col, int fq) const {
        const u32x2 g = *(const u32x2*)(gate + (size_t)row * NPROJ + col); bf16_t* op = mb + (size_t)row * DM + col;
        float r0 = sigm(bflo(g.x)) * a[0], r1 = sigm(bfhi(g.x)) * a[1], r2 = sigm(bflo(g.y)) * a[2], r3 = sigm(bfhi(g.y)) * a[3];
        if (ADD) { const u32x2 o = *(const u32x2*)op; r0 += bflo(o.x); r1 += bfhi(o.x); r2 += bflo(o.y); r3 += bfhi(o.y); }
        u32x2 w; w.x = pk_bf16(r0, r1); w.y = pk_bf16(r2, r3); *(u32x2*)op = w;
    }
};
struct TailResid {
    bf16_t* xb; float* ssn;
    __device__ __forceinline__ void operator()(const f32x4 a, int row, int col, int fq) const {
        bf16_t* bp = xb + (size_t)row * DM + col; const u32x2 o = *(const u32x2*)bp;
        u32x2 w; w.x = pk_bf16(bflo(o.x) + a[0], bfhi(o.x) + a[1]); w.y = pk_bf16(bflo(o.y) + a[2], bfhi(o.y) + a[3]); *(u32x2*)bp = w;
        const float r0 = bflo(w.x), r1 = bfhi(w.x), r2 = bflo(w.y), r3 = bfhi(w.y);
        float s = (r0 * r0 + r1 * r1) + (r2 * r2 + r3 * r3); s += __shfl_xor(s, 16); s += __shfl_xor(s, 32);
        if (fq == 0) atomicAdd(ssn + row, s);
    }
};
template <class TE> __device__ __forceinline__ void tail_gemm(LAS unsigned char* lds, const bf16_t* A, const bf16_t* Bt, int K, const TE& E) {
    const int tid = ltid(), lane = tid & 63, w = __builtin_amdgcn_readfirstlane(tid >> 6), fr = lane & 15, fq = lane >> 4, G = gridDim.x, wp = w & 3, half = w >> 2, Kh = K >> 1;
    LAS f32x4* xch = (LAS f32x4*)lds;
    const int ntrip = (1024 + 4 * G - 1) / (4 * G);
    for (int trip = 0; trip < ntrip; ++trip) {
        const int tile = wp * G + (int)blockIdx.x + trip * 4 * G; const bool ok = tile < 1024;
        const int tm = tile >> 6, tn = tile & 63;
        f32x4 acc = {0.f, 0.f, 0.f, 0.f};
        if (ok) { const bf16_t* ap = A + (size_t)(NREAL + tm * 16 + fr) * K + half * Kh + 8 * fq; const bf16_t* bp = Bt + (size_t)(tn * 16 + fr) * K + half * Kh + 8 * fq;
#pragma unroll 16
            for (int k0 = 0; k0 < Kh; k0 += 32) { const bf16x8 a = *(const bf16x8*)(ap + k0), b = *(const bf16x8*)(bp + k0); acc = __builtin_amdgcn_mfma_f32_16x16x32_bf16(b, a, acc, 0, 0, 0); } }
        __syncthreads();
        if (half == 1) xch[wp * 64 + lane] = acc;
        __syncthreads();
        if (half == 0 && ok) { acc += xch[wp * 64 + lane]; E(acc, NREAL + tm * 16 + fr, tn * 16 + 4 * fq, fq); }
    }
    __syncthreads();
}
__device__ __forceinline__ unsigned char* gla_seg(unsigned char* gkbytes, unsigned char* g0, int b, int h, int c, int t) {
    return c == 0 ? g0 + ((size_t)((b * 4 + h) * 64 + t)) * 512 : gkbytes + ((size_t)(b * 2048 + (c - 1) * 64 + t) * 512 + h * 128) * 4;
}
struct GlaPre { u32x4 rq[2], rk[2], rg[4]; };
__device__ __forceinline__ void gla_pre_load(GlaPre& R, int item, const bf16_t* proj, const float* gkb) {
    const int tid = ltid(), c = item % 33, bh = item / 33, b = bh >> 2, h = bh & 3, nv = c == 0 ? 16 : 64;
    const int qt0 = tid >> 4, qc = tid & 15, gt0 = tid >> 5, gc = tid & 31; const u32x4 z4 = {0u, 0u, 0u, 0u};
#pragma unroll
    for (int i = 0; i < 2; ++i) { const int t = qt0 + 32 * i; const int row = c == 0 ? NREAL + b * 16 + t : b * 2048 + (c - 1) * 64 + t; const bf16_t* p = proj + (size_t)row * NPROJ + h * 128 + qc * 8;
        R.rq[i] = t < nv ? __builtin_nontemporal_load((const u32x4*)(p + C_Q)) : z4; R.rk[i] = t < nv ? __builtin_nontemporal_load((const u32x4*)(p + C_K)) : z4; }
#pragma unroll
    for (int i = 0; i < 4; ++i) { const int t = gt0 + 16 * i; const int row = c == 0 ? NREAL + b * 16 + t : b * 2048 + (c - 1) * 64 + t; R.rg[i] = t < nv ? __builtin_nontemporal_load((const u32x4*)(gkb + (size_t)row * 512 + h * 128 + gc * 4)) : z4; }
}
__device__ __forceinline__ void gla_pre_item(LAS unsigned char* lds, int item, bf16_t* proj, float* gkb, unsigned char* g0, const GlaPre& R) {
    const int tid = ltid(), lane = tid & 63, w = __builtin_amdgcn_readfirstlane(tid >> 6), fr = lane & 15, fq = lane >> 4;
    const int c = item % 33, bh = item / 33, b = bh >> 2, h = bh & 3, nv = c == 0 ? 16 : 64;
    LAS bf16_t* QT = (LAS bf16_t*)lds; LAS bf16_t* KT = (LAS bf16_t*)(lds + 17408); LAS float* GK = (LAS float*)(lds + 34816); LAS bf16_t* KH = (LAS bf16_t*)(lds + 67584);
    LAS bf16_t* AM = (LAS bf16_t*)(lds + 95232); LAS float* PT = (LAS float*)(lds + 121856); LAS float* DC = (LAS float*)(lds + 125952);
    const int qt0 = tid >> 4, qc = tid & 15, gt0 = tid >> 5, gc = tid & 31;
#define GLA_ROW(c, t) ((c) == 0 ? NREAL + b * 16 + (t) : b * 2048 + ((c) - 1) * 64 + (t))
    GLA_SYNC();
    {
#pragma unroll
      for (int i = 0; i < 2; ++i) { const int t = qt0 + 32 * i; *(LAS u32x4*)(QT + t * QS + qc * 8) = R.rq[i]; *(LAS u32x4*)(KT + t * QS + qc * 8) = R.rk[i]; }
#pragma unroll
      for (int i = 0; i < 4; ++i) { const int t = gt0 + 16 * i; *(LAS u32x4*)(GK + t * 128 + gc * 4) = R.rg[i]; } }
    GLA_SYNC();
        { typedef float f32x2_t __attribute__((ext_vector_type(2)));
          const int d2 = (tid & 63) * 2, part = w, t0 = part * 8;
          float c0[8], c1[8]; float r0 = 0.f, r1 = 0.f;
#pragma unroll
          for (int i = 0; i < 8; ++i) { const f32x2_t g = *(const LAS f32x2_t*)(GK + (t0 + i) * 128 + d2); r0 += g.x * 1.44269504f; r1 += g.y * 1.44269504f; c0[i] = r0; c1[i] = r1; }
          *(LAS f32x2_t*)(PT + part * 128 + d2) = (f32x2_t){r0, r1};
          GLA_SYNC();
          float o0 = 0.f, o1 = 0.f, bl0 = 0.f, bl1 = 0.f;
#pragma unroll
          for (int p = 0; p < 8; ++p) { const f32x2_t v = *(const LAS f32x2_t*)(PT + p * 128 + d2); if (p < part) { o0 += v.x; o1 += v.y; } bl0 += v.x; bl1 += v.y; }
          const float E0 = __builtin_amdgcn_exp2f(bl0), E1 = __builtin_amdgcn_exp2f(bl1);
          unsigned kh0[4], kh1[4];
#pragma unroll
          for (int i = 0; i < 8; i += 2) {
              LAS unsigned* qp0 = (LAS unsigned*)(QT + (t0 + i) * QS + d2); LAS unsigned* qp1 = (LAS unsigned*)(QT + (t0 + i + 1) * QS + d2);
              LAS unsigned* kp0 = (LAS unsigned*)(KT + (t0 + i) * QS + d2); LAS unsigned* kp1 = (LAS unsigned*)(KT + (t0 + i + 1) * QS + d2);
              const unsigned qa = *qp0, qb = *qp1, ka = *kp0, kb = *kp1;
              const float b00 = o0 + c0[i], b01 = o1 + c1[i], b10 = o0 + c0[i + 1], b11 = o1 + c1[i + 1];
              const float n00 = bflo(ka) * __builtin_amdgcn_exp2f(-b00), n01 = bfhi(ka) * __builtin_amdgcn_exp2f(-b01), n10 = bflo(kb) * __builtin_amdgcn_exp2f(-b10), n11 = bfhi(kb) * __builtin_amdgcn_exp2f(-b11);
              *qp0 = pk_bf16(bflo(qa) * __builtin_amdgcn_exp2f(b00), bfhi(qa) * __builtin_amdgcn_exp2f(b01)); *qp1 = pk_bf16(bflo(qb) * __builtin_amdgcn_exp2f(b10), bfhi(qb) * __builtin_amdgcn_exp2f(b11));
              *kp0 = pk_bf16(n00, n01); *kp1 = pk_bf16(n10, n11);
              kh0[i >> 1] = pk_bf16(n00 * E0, n10 * E0); kh1[i >> 1] = pk_bf16(n01 * E1, n11 * E1); }
          *(LAS u32x4*)(KH + d2 * VS_ + t0) = (u32x4){kh0[0], kh0[1], kh0[2], kh0[3]}; *(LAS u32x4*)(KH + (d2 + 1) * VS_ + t0) = (u32x4){kh1[0], kh1[1], kh1[2], kh1[3]};
          if (part == 0) { DC[d2] = E0; DC[d2 + 1] = E1; } }
        GLA_SYNC();
        { const int ti = w >> 1;
#pragma unroll
          for (int jj = 0; jj < 2; ++jj) { const int sj = (w & 1) * 2 + jj; f32x4 acc = {0.f, 0.f, 0.f, 0.f};
              if (sj <= ti) {
#pragma unroll
                  for (int kk = 0; kk < 4; ++kk) { const bf16x8 ao = *(const LAS bf16x8*)(KT + (16 * sj + fr) * QS + 32 * kk + 8 * fq), bo = *(const LAS bf16x8*)(QT + (16 * ti + fr) * QS + 32 * kk + 8 * fq);
                      acc = __builtin_amdgcn_mfma_f32_16x16x32_bf16(ao, bo, acc, 0, 0, 0); }
                  if (sj == ti) {
#pragma unroll
                      for (int e = 0; e < 4; ++e) if (4 * fq + e > fr) acc[e] = 0.f; }
              }
              u32x2 wv; wv.x = pk_bf16(acc[0], acc[1]); wv.y = pk_bf16(acc[2], acc[3]);
              *(LAS u32x2*)(AM + (16 * ti + fr) * VS_ + 16 * sj + 4 * fq) = wv; } }
        GLA_SYNC();
    unsigned char* gkbytes = (unsigned char*)gkb;
#pragma unroll
    for (int i = 0; i < 2; ++i) { const int t = qt0 + 32 * i; if (t < nv) *(u32x4*)(proj + (size_t)GLA_ROW(c, t) * NPROJ + C_Q + h * 128 + qc * 8) = *(const LAS u32x4*)(QT + t * QS + qc * 8); }
#pragma unroll
    for (int j = 0; j < 2; ++j) { const int i = tid + 512 * j, d = i >> 3, pc = i & 7; *(u32x4*)(gla_seg(gkbytes, g0, b, h, c, d >> 1) + (d & 1) * 128 + pc * 16) = *(const LAS u32x4*)(KH + d * VS_ + pc * 8); }
    { const int t = tid >> 3, pc = tid & 7; *(u32x4*)(gla_seg(gkbytes, g0, b, h, c, t) + 256 + pc * 16) = *(const LAS u32x4*)(AM + t * VS_ + pc * 8); }
    if (tid < 64) { typedef float f32x2_t __attribute__((ext_vector_type(2))); *(f32x2_t*)(gla_seg(gkbytes, g0, b, h, c, tid) + 384) = *(const LAS f32x2_t*)(DC + 2 * tid); }
#undef GLA_ROW
}

struct GlaSet { u32x4 rq[2], rkh[2], ram, rv; u32x2 rdc; };
struct GlaSeqCtx { const bf16_t* proj; unsigned char* gkbytes; unsigned char* g0; bf16_t* obuf; float* ossq; int b, h, vs, tid, w, fr, fq; bool do_atomic; };
#define GLA_ROW(c, t) ((c) == 0 ? NREAL + X.b * 16 + (t) : X.b * 2048 + ((c) - 1) * 64 + (t))
__device__ __forceinline__ void gla_seq_prefetch(GlaSet& R, const GlaSeqCtx& X, int c) {
    const int tid = X.tid, qt0 = tid >> 4, qc = tid & 15, vt = tid >> 3, vc = tid & 7, nv = c == 0 ? 16 : 64; const u32x4 z4 = {0u, 0u, 0u, 0u};
#pragma unroll
    for (int i = 0; i < 2; ++i) { const int t = qt0 + 32 * i; R.rq[i] = t < nv ? *(const u32x4*)(X.proj + (size_t)GLA_ROW(c, t) * NPROJ + C_Q + X.h * 128 + qc * 8) : z4; }
#pragma unroll
    for (int j = 0; j < 2; ++j) { const int i = tid + 512 * j, d = i >> 3, pc = i & 7; R.rkh[j] = *(const u32x4*)(gla_seg(X.gkbytes, X.g0, X.b, X.h, c, d >> 1) + (d & 1) * 128 + pc * 16); }
    R.ram = *(const u32x4*)(gla_seg(X.gkbytes, X.g0, X.b, X.h, c, vt) + 256 + vc * 16);
    R.rv = vt < nv ? __builtin_nontemporal_load((const u32x4*)(X.proj + (size_t)GLA_ROW(c, vt) * NPROJ + C_V + X.h * 256 + X.vs * 64 + vc * 8)) : z4;
    R.rdc = (u32x2){0u, 0u}; if (tid < 64) R.rdc = *(const u32x2*)(gla_seg(X.gkbytes, X.g0, X.b, X.h, c, tid) + 384);
}
__device__ __forceinline__ void gla_seq_chunk(LAS unsigned char* lds, GlaSet& R, const GlaSeqCtx& X, int c, f32x4 (&sacc)[4], u32x2& ow0, u32x2& ow1, float& osq, int& orow) {
    const int tid = X.tid, w = X.w, fr = X.fr, fq = X.fq, h = X.h, vs = X.vs, qt0 = tid >> 4, qc = tid & 15, vt = tid >> 3, vc = tid & 7;
    LAS bf16_t* QT = (LAS bf16_t*)lds; LAS bf16_t* KH = (LAS bf16_t*)(lds + 17408); LAS bf16_t* VT = (LAS bf16_t*)(lds + 35840); LAS bf16_t* AM = (LAS bf16_t*)(lds + 45056);
    LAS bf16_t* ST = (LAS bf16_t*)(lds + 54272); LAS float* DC = (LAS float*)(lds + 71680);
#pragma unroll
    for (int i = 0; i < 2; ++i) { const int t = qt0 + 32 * i; *(LAS u32x4*)(QT + t * QS + qc * 8) = R.rq[i]; }
#pragma unroll
    for (int j = 0; j < 2; ++j) { const int i = tid + 512 * j, d = i >> 3, pc = i & 7; *(LAS u32x4*)(KH + d * VS_ + pc * 8) = R.rkh[j]; }
    *(LAS u32x4*)(AM + vt * VS_ + vc * 8) = R.ram;
    { const u32x4 rv = R.rv; LAS bf16_t* vp = VT + (vc * 8) * VS_ + vt;
      vp[0 * VS_] = (bf16_t)(rv.x & 0xffffu); vp[1 * VS_] = (bf16_t)(rv.x >> 16); vp[2 * VS_] = (bf16_t)(rv.y & 0xffffu); vp[3 * VS_] = (bf16_t)(rv.y >> 16);
      vp[4 * VS_] = (bf16_t)(rv.z & 0xffffu); vp[5 * VS_] = (bf16_t)(rv.z >> 16); vp[6 * VS_] = (bf16_t)(rv.w & 0xffffu); vp[7 * VS_] = (bf16_t)(rv.w >> 16); }
    if (tid < 64) *(LAS u32x2*)(DC + 2 * tid) = R.rdc;
    if (orow >= 0) { bf16_t* op_ = X.obuf + (size_t)orow * DM + h * 256 + vs * 64 + 32 * (w & 1) + 4 * fq; *(u32x2*)op_ = ow0; *(u32x2*)(op_ + 16) = ow1;
        float s_ = osq; s_ += __shfl_xor(s_, 16); s_ += __shfl_xor(s_, 32);
        if (fq == 0 && X.do_atomic) __hip_atomic_fetch_add((__attribute__((address_space(1))) float*)(X.ossq + (size_t)orow * 4 + h), s_, __ATOMIC_RELAXED, __HIP_MEMORY_SCOPE_AGENT); }
    GLA_SYNC();
    if (c + 2 < 33) gla_seq_prefetch(R, X, c + 2);
        { const int ti = w >> 1; const int t = 16 * ti + fr; const int nv = c == 0 ? 16 : 64; float sq = 0.f;
          const int row = GLA_ROW(c, t);
#pragma unroll
          for (int jj = 0; jj < 2; ++jj) { const int jv = (w & 1) * 2 + jj; f32x4 acc = {0.f, 0.f, 0.f, 0.f};
#pragma unroll
              for (int kk = 0; kk < 2; ++kk) { const bf16x8 ao = *(const LAS bf16x8*)(VT + (16 * jv + fr) * VS_ + 32 * kk + 8 * fq), bo = *(const LAS bf16x8*)(AM + (16 * ti + fr) * VS_ + 32 * kk + 8 * fq);
                  acc = __builtin_amdgcn_mfma_f32_16x16x32_bf16(ao, bo, acc, 0, 0, 0); }
#pragma unroll
              for (int kk = 0; kk < 4; ++kk) { const bf16x8 ao = *(const LAS bf16x8*)(ST + (16 * jv + fr) * QS + 32 * kk + 8 * fq), bo = *(const LAS bf16x8*)(QT + (16 * ti + fr) * QS + 32 * kk + 8 * fq);
                  acc = __builtin_amdgcn_mfma_f32_16x16x32_bf16(ao, bo, acc, 0, 0, 0); }
              sq += (acc[0] * acc[0] + acc[1] * acc[1]) + (acc[2] * acc[2] + acc[3] * acc[3]);
              { u32x2 wv; wv.x = pk_bf16(acc[0], acc[1]); wv.y = pk_bf16(acc[2], acc[3]); if (jj == 0) ow0 = wv; else ow1 = wv; } }
          osq = sq; orow = t < nv ? row : -1; }
        { const int jv = w >> 1;
#pragma unroll
          for (int x = 0; x < 4; ++x) { const int jd = (w & 1) * 4 + x; const float dcy = DC[16 * jd + fr]; sacc[x] = sacc[x] * dcy;
#pragma unroll
              for (int kk = 0; kk < 2; ++kk) { const bf16x8 ao = *(const LAS bf16x8*)(VT + (16 * jv + fr) * VS_ + 32 * kk + 8 * fq), bo = *(const LAS bf16x8*)(KH + (16 * jd + fr) * VS_ + 32 * kk + 8 * fq);
                  sacc[x] = __builtin_amdgcn_mfma_f32_16x16x32_bf16(ao, bo, sacc[x], 0, 0, 0); } } }
    GLA_SYNC();
        { const int jv = w >> 1;
#pragma unroll
          for (int x = 0; x < 4; ++x) { const int jd = (w & 1) * 4 + x;
#pragma unroll
              for (int e = 0; e < 4; ++e) ST[(16 * jv + 4 * fq + e) * QS + 16 * jd + fr] = f2bf(sacc[x][e]); } }
}
__device__ __forceinline__ void gla_seq_item(LAS unsigned char* lds, int item, const bf16_t* proj, unsigned char* gkbytes, unsigned char* g0, bf16_t* obuf, float* ossq, float* pgla, bool do_atomic = true) {
    GlaSeqCtx X; X.proj = proj; X.gkbytes = gkbytes; X.g0 = g0; X.obuf = obuf; X.ossq = ossq; X.do_atomic = do_atomic;
    X.tid = ltid(); const int lane = X.tid & 63; X.w = __builtin_amdgcn_readfirstlane(X.tid >> 6); X.fr = lane & 15; X.fq = lane >> 4;
    { const int xcd = item & 7, j = item >> 3, bh = xcd + 8 * (j >> 2); X.vs = j & 3; X.b = bh >> 2; X.h = bh & 3; }
    LAS bf16_t* ST = (LAS bf16_t*)(lds + 54272);
    GLA_SYNC();
    for (int i = X.tid; i < 64 * QS / 2; i += 512) ((LAS unsigned*)ST)[i] = 0u;
    f32x4 sacc[4];
#pragma unroll
    for (int x = 0; x < 4; ++x) sacc[x] = (f32x4){0.f, 0.f, 0.f, 0.f};
    u32x2 ow0 = {0u, 0u}, ow1 = {0u, 0u}; float osq = 0.f; int orow = -1;
    GlaSet R0, R1;
    gla_seq_prefetch(R0, X, 0); gla_seq_prefetch(R1, X, 1);
    for (int c = 0; c < 32; c += 2) { gla_seq_chunk(lds, R0, X, c, sacc, ow0, ow1, osq, orow); gla_seq_chunk(lds, R1, X, c + 1, sacc, ow0, ow1, osq, orow); }
    gla_seq_chunk(lds, R0, X, 32, sacc, ow0, ow1, osq, orow);
    { const int w = X.w, fr = X.fr, fq = X.fq, h = X.h, vs = X.vs;
      if (orow >= 0) { bf16_t* op_ = obuf + (size_t)orow * DM + h * 256 + vs * 64 + 32 * (w & 1) + 4 * fq; *(u32x2*)op_ = ow0; *(u32x2*)(op_ + 16) = ow1;
          float s_ = osq; s_ += __shfl_xor(s_, 16); s_ += __shfl_xor(s_, 32);
          if (fq == 0 && do_atomic) __hip_atomic_fetch_add((__attribute__((address_space(1))) float*)(ossq + (size_t)orow * 4 + h), s_, __ATOMIC_RELAXED, __HIP_MEMORY_SCOPE_AGENT); }
      const int jv = w >> 1;
#pragma unroll
      for (int x = 0; x < 4; ++x) { const int d = 16 * ((w & 1) * 4 + x) + fr; __builtin_nontemporal_store(sacc[x], (f32x4*)(pgla + ((size_t)((X.b * 4 + h) * 128 + d)) * 256 + vs * 64 + 16 * jv + 4 * fq)); } }
}
#undef GLA_ROW
#define XB_TMO      128
#define XB_XCNT(j)  (256  + 64 * (j))
#define XB_XSUB(j)  (1280 + 64 * (j))
#define XB_XGEN(j)  (2304 + 64 * (j))
#define XB_TOP      3328
#define XB_TOPGEN   3392
#define XCD_BAR_WORDS 3456
#define XB_SPIN_CAP (1u << 18)

__device__ __forceinline__ unsigned xb_ld(unsigned* p)              { return __hip_atomic_load(p, __ATOMIC_RELAXED, __HIP_MEMORY_SCOPE_AGENT); }
__device__ __forceinline__ unsigned xb_add(unsigned* p, unsigned v) { return __hip_atomic_fetch_add(p, v, __ATOMIC_RELAXED, __HIP_MEMORY_SCOPE_AGENT); }
__device__ __forceinline__ unsigned xb_xcc_id() { return (unsigned)__builtin_amdgcn_s_getreg((3 << 11) | 20) & 0xFu; }
#define XB_SPIN(cond, bar) do { unsigned _sp = 0; while (cond) { __builtin_amdgcn_s_sleep(1); \
    if ((++_sp & 255u) == 0u) { if (xb_ld(&(bar)[XB_TMO])) break; if (_sp > XB_SPIN_CAP) { atomicAdd(&(bar)[XB_TMO], 1u); break; } } } } while (0)

struct XcdBarrier {
    unsigned* bar; unsigned x;
    volatile LAS unsigned* st;
};

__device__ __forceinline__ XcdBarrier xcd_barrier_post(unsigned* bar, volatile LAS unsigned* st) {
    XcdBarrier b; b.bar = bar; b.x = xb_xcc_id(); b.st = st;
    if (threadIdx.x == 0) (void)xb_add(&bar[XB_XCNT(b.x)], 1u);
    return b;
}
__device__ __forceinline__ void xcd_barrier_complete(unsigned* bar, unsigned x, unsigned& nloc, unsigned& nx) {
    const unsigned G = gridDim.x * gridDim.y * gridDim.z;
    unsigned sum, cnt, mine, sp = 0u;
    for (;;) {
        sum = 0u; cnt = 0u; mine = 0u;
#pragma unroll
        for (unsigned j = 0; j < 16; ++j) { const unsigned c = xb_ld(&bar[XB_XCNT(j)]); sum += c; cnt += (c > 0u) ? 1u : 0u; mine = (j == x) ? c : mine; }
        if (sum == G) break;
        __builtin_amdgcn_s_sleep(1);
        if ((++sp & 255u) == 0u) { if (xb_ld(&bar[XB_TMO])) break; if (sp > XB_SPIN_CAP) { atomicAdd(&bar[XB_TMO], 1u); break; } }
    }
    nloc = mine > 0u ? mine : 1u; nx = cnt > 0u ? cnt : 1u;
}

__device__ __forceinline__ void xcd_barrier(const XcdBarrier& b) {
    asm volatile("s_waitcnt vmcnt(0)" ::: "memory");
    __syncthreads();
    if (threadIdx.x == 0) {
        unsigned* bar = b.bar;
        __builtin_amdgcn_s_waitcnt(0);
        unsigned nloc = b.st[0], nx = b.st[1];
        if (nloc == 0u) { xcd_barrier_complete(bar, b.x, nloc, nx); b.st[0] = nloc; b.st[1] = nx; }
        const unsigned old = xb_add(&bar[XB_XSUB(b.x)], 1u);
        const unsigned gen = old / nloc;
        if (old + 1u == (gen + 1u) * nloc) {
            __builtin_amdgcn_fence(__ATOMIC_RELEASE, "agent");
            asm volatile("s_waitcnt vmcnt(0)" ::: "memory");
            const unsigned og = xb_add(&bar[XB_TOP], 1u);
            const unsigned tg = og / nx;
            if (og + 1u == (tg + 1u) * nx) xb_add(&bar[XB_TOPGEN], 1u);
            else XB_SPIN(xb_ld(&bar[XB_TOPGEN]) == tg, bar);
            __builtin_amdgcn_fence(__ATOMIC_ACQUIRE, "agent");
            xb_add(&bar[XB_XGEN(b.x)], 1u);
            asm volatile("s_waitcnt vmcnt(0)" ::: "memory");
        } else {
            XB_SPIN(xb_ld(&bar[XB_XGEN(b.x)]) == gen, bar);
            __builtin_amdgcn_fence(__ATOMIC_ACQUIRE, "agent");
            asm volatile("s_waitcnt vmcnt(0)" ::: "memory");
        }
    }
    __syncthreads();
}
constexpr int LDS_BYTES = 133120;

__device__ __forceinline__ KP kargs() {
#if defined(__HIP_DEVICE_COMPILE__)
    KP p = (KP)__builtin_amdgcn_kernarg_segment_ptr(); asm volatile("" : "+s"(p)); return p;
#else
    return nullptr;
#endif
}
__device__ __forceinline__ void gsync1(cg::grid_group& grid) {
    asm volatile("s_waitcnt vmcnt(0) lgkmcnt(0)" ::: "memory");
    __syncthreads();
    if (threadIdx.x < 64) asm volatile("buffer_wbl2 sc1\n\ts_waitcnt vmcnt(0)" ::: "memory");
    grid.sync();
    asm volatile("buffer_inv sc1\n\ts_waitcnt vmcnt(0)" ::: "memory");
}
__device__ __forceinline__ void touch_weights(LAS unsigned char* lds, const unsigned char* w, size_t bytes, int G, int bx) {
    const int tid = ltid(), wid = __builtin_amdgcn_readfirstlane(tid >> 6); LAS unsigned* dst = (LAS unsigned*)(lds + wid * 256);
    const size_t nlines = bytes >> 7;
    for (size_t i = (size_t)bx * 512 + tid; i < nlines; i += (size_t)G * 512) __builtin_amdgcn_global_load_lds((const unsigned*)(w + (i << 7)), dst, 4, 0, 0);
}
constexpr int CONV_SPLIT = 768;
constexpr size_t WS_BAR = 896 * 1024;
#ifdef EXP_SYNC2
#define gsync(grid) do { xcd_barrier(xbar); xcd_barrier(xbar); } while (0)
#else
#define gsync(grid) xcd_barrier(xbar)
#endif
#define PHASE_PTRS const KP kp = kargs(); \
    float* ss = (float*)(GP(unsigned char, 19) + WS_SS); float* xtail = (float*)(GP(unsigned char, 19) + WS_XTAIL); \
    bf16_t* xb = (bf16_t*)(GP(unsigned char, 19) + WS_XB); float* gk = (float*)(GP(unsigned char, 19) + WS_GK); bf16_t* mb = (bf16_t*)(GP(unsigned char, 19) + WS_GK); \
    bf16_t* a_in = (bf16_t*)(GP(unsigned char, 19) + WS_AIN); bf16_t* b_in = (bf16_t*)(GP(unsigned char, 19) + WS_BIN); bf16_t* obuf = (bf16_t*)(GP(unsigned char, 19) + WS_OB); \
    bf16_t* proj = (bf16_t*)(GP(unsigned char, 19) + WS_PROJ); bf16_t* hb = (bf16_t*)(GP(unsigned char, 19) + WS_PROJ); \
    unsigned char* wl = GP(unsigned char, 19) + WS_W + (size_t)l * W_LAYER; float* ossq = ss + 5 * M_ROWS + (size_t)l * M_ROWS * 4; \
    (void)ss; (void)xtail; (void)xb; (void)gk; (void)mb; (void)a_in; (void)b_in; (void)obuf; (void)proj; (void)hb; (void)wl; (void)ossq;
#ifndef DBG_CUT
#define DBG_CUT 0
#endif
__device__ __forceinline__ void dbg_dump(const KP kp, const bf16_t* b0, const bf16_t* b1) {
    float* out = GP(float, 18); const int gt = blockIdx.x * 512 + ltid(), NT = gridDim.x * 512;
    for (int i = gt; i < 16777216; i += NT) out[i] = bf2f(b0[i]);
    for (int i = gt; i < 16777216; i += NT) out[O_SGLA + 16777216 + i] = bf2f(b1[i]);
}
__global__ void __launch_bounds__(512, 2) fwd_kernel(Args a_unused) {
    extern __shared__ __attribute__((aligned(16))) unsigned char lds_raw[];
    LAS unsigned char* lds = (LAS unsigned char*)lds_raw;
    cg::grid_group grid = cg::this_grid();
    const int G = gridDim.x, bx = blockIdx.x;

    volatile LAS unsigned* xst = (volatile LAS unsigned*)(lds + 131072 + 64);
    if (threadIdx.x < 2) xst[threadIdx.x] = 0u;
    { const KP kp = kargs(); unsigned* bw = (unsigned*)(GP(unsigned char, 19) + WS_BAR);
      for (int i = bx * 512 + ltid(); i < XCD_BAR_WORDS; i += G * 512) bw[i] = 0u; }
    gsync1(grid);
    XcdBarrier xbar;
    { const KP kp = kargs(); xbar = xcd_barrier_post((unsigned*)(GP(unsigned char, 19) + WS_BAR), xst); }
    { const KP kp = kargs(); p0_prologue(kp, lds);
#ifdef EXP_P0x2
      __syncthreads(); p0_prologue(kp, lds);
#endif
    }
    gsync(grid);

    for (int l = 0; l < 2; ++l) {
#ifndef NO_PH_GEMM1
        { PHASE_PTRS pg8::Gemm g{xb, (const bf16_t*)wl, M_ROWS, NGEMM1, DM}; pg8::StaticOrder S; S.init(M_ROWS, NGEMM1, G, bx);
          pg8::EpiProj E{proj, gk, ss + (size_t)(2 * l) * M_ROWS, GP(const float, 8) + l * 512};
          pg8::gemm_phase<pg8::EpiProj, pg8::StaticOrder, true, true>(lds, g, S, E);
#ifdef EXP_G1x2
          gsync(grid); pg8::gemm_phase<pg8::EpiProj, pg8::StaticOrder, true, true>(lds, g, S, E);
#endif
#ifdef EXP_G1x3
          gsync(grid); pg8::gemm_phase<pg8::EpiProj, pg8::StaticOrder, true, true>(lds, g, S, E);
#endif
          }
#endif
        gsync(grid);
#if DBG_CUT == 8
        { const KP kp = kargs(); float* out = GP(float, 18); const bf16_t* pj = (const bf16_t*)(GP(unsigned char, 19) + WS_PROJ); const int gt = blockIdx.x * 512 + ltid(), NT = gridDim.x * 512;
          for (int i = gt; i < 2 * 16777216; i += NT) { const int row = i >> 11, col = 3072 + (i & 2047); if (row < M_ROWS) { const float v = bf2f(pj[(size_t)row * NPROJ + col]); if (i < 16777216) out[i] = v; else out[O_SGLA + i] = v; } } return; }
#endif
#if DBG_CUT == 7
        { const KP kp = kargs(); float* out = GP(float, 18); const float* g = (const float*)(GP(unsigned char, 19) + WS_GK); const int gt = blockIdx.x * 512 + ltid(), NT = gridDim.x * 512;
          for (int i = gt; i < M_ROWS * 512; i += NT) out[i] = g[i]; return; }
#endif
#if DBG_CUT == 1
        { const KP kp = kargs(); dbg_dump(kp, (const bf16_t*)(GP(unsigned char, 19) + WS_PROJ), (const bf16_t*)(GP(unsigned char, 19) + WS_PROJ) + 8192 * 4096); return; }
#endif
        { PHASE_PTRS unsigned char* g0 = GP(unsigned char, 19) + WS_G0;
          { GlaPre A, B;
#pragma unroll
            for (int i = 0; i < 2; ++i) { A.rq[i] = B.rq[i] = (u32x4){0u, 0u, 0u, 0u}; A.rk[i] = B.rk[i] = (u32x4){0u, 0u, 0u, 0u}; }
#pragma unroll
            for (int i = 0; i < 4; ++i) A.rg[i] = B.rg[i] = (u32x4){0u, 0u, 0u, 0u};
            int it = bx; if (it < 1056) gla_pre_load(A, it, proj, gk);
            while (it < 1056) { const int itn = it + G; if (itn < 1056) gla_pre_load(B, itn, proj, gk); gla_pre_item(lds, it, proj, gk, g0, A); A = B; it = itn; } }
          for (int it = bx; it < CONV_SPLIT; it += 2 * G) conv_prompt2(it, G, CONV_SPLIT, l, proj, GP(const float, 6), a_in, GP(float, 18) + O_PCONV); }
        gsync(grid);
        { PHASE_PTRS unsigned char* g0 = GP(unsigned char, 19) + WS_G0;
          const int ng = G >= 256 ? 128 : (G > 1 ? G / 2 : 1);
          if (bx < ng) { for (int item = bx; item < 128; item += ng) gla_seq_item(lds, item, proj, (unsigned char*)gk, g0, obuf, ossq, GP(float, 18) + O_PGLA + (size_t)l * 8 * 4 * 128 * 256); }
          if (bx >= ng || G == 1) { const int nb = G == 1 ? 1 : G - ng, b0 = G == 1 ? 0 : bx - ng;
              for (int it = b0; it < 512; it += nb) gla_sample_item(lds, it, l, proj, gk, GP(const float, 3), GP(float, 18) + O_SGLA, GP(const float, 9) + l * 256, b_in);
              for (int it = CONV_SPLIT + b0; it < NPROMPT / 4; it += 2 * nb) conv_prompt2(it, nb, NPROMPT / 4, l, proj, GP(const float, 6), a_in, GP(float, 18) + O_PCONV);
              for (int it = NPROMPT / 4 + b0; it < M_ROWS / 4; it += nb) conv_rows(it, l, proj, GP(const float, 6), GP(const float, 2), a_in, GP(float, 18) + O_PCONV, GP(float, 18) + O_SCONV); } }
        gsync(grid);
        { PHASE_PTRS for (int it = bx; it < NPROMPT / 4; it += 4 * G) prep_rows4(it, G, proj, obuf, ossq, GP(const float, 9) + l * 256, b_in);
          touch_weights(lds, wl + W_A, 6 * MiB, G, bx); }
        gsync(grid);
#if DBG_CUT == 3
        { const KP kp = kargs(); dbg_dump(kp, (const bf16_t*)(GP(unsigned char, 19) + WS_BIN), (const bf16_t*)(GP(unsigned char, 19) + WS_OB)); return; }
#endif
        { PHASE_PTRS pg8::Gemm g{a_in, (const bf16_t*)(wl + W_A), NREAL, DM, DM, b_in, (const bf16_t*)(wl + W_B)}; pg8::PairOrder S; S.init(NREAL, DM, G, bx);
          pg8::EpiGate2 E{proj + C_GA, proj + C_GBB, mb};
          pg8::gemm_phase<pg8::EpiGate2, pg8::PairOrder, true, true>(lds, g, S, E);
          TailGate<false> TA{proj + C_GA, mb}; tail_gemm(lds, a_in, (const bf16_t*)(wl + W_A), DM, TA);
          TailGate<true> TB{proj + C_GBB, mb}; tail_gemm(lds, b_in, (const bf16_t*)(wl + W_B), DM, TB); }
        gsync(grid);
#if DBG_CUT == 4
        { const KP kp = kargs(); dbg_dump(kp, (const bf16_t*)(GP(unsigned char, 19) + WS_GK), (const bf16_t*)(GP(unsigned char, 19) + WS_BIN)); return; }
#endif
#ifndef NO_PH_GEMM3
        { PHASE_PTRS pg8::Gemm g{mb, (const bf16_t*)(wl + W_O), NREAL, DM, DM}; pg8::StaticOrder S; S.init(NREAL, DM, G, bx);
          pg8::EpiResid E{xb, ss + (size_t)(2 * l + 1) * M_ROWS};
          pg8::gemm_phase<pg8::EpiResid, pg8::StaticOrder, true, true>(lds, g, S, E);
          TailResid TE{xb, ss + (size_t)(2 * l + 1) * M_ROWS}; tail_gemm(lds, mb, (const bf16_t*)(wl + W_O), DM, TE);
          touch_weights(lds, wl + W_GU, 11 * MiB, G, bx); }
#endif
        gsync(grid);
#if DBG_CUT == 5
        { const KP kp = kargs(); dbg_dump(kp, (const bf16_t*)(GP(unsigned char, 19) + WS_XB), (const bf16_t*)(GP(unsigned char, 19) + WS_GK)); return; }
#endif
#ifndef NO_PH_GEMM4
        { PHASE_PTRS pg8::Gemm g{xb, (const bf16_t*)(wl + W_GU), M_ROWS, 2 * DFF, DM}; pg8::StaticOrder S; S.init(M_ROWS, 2 * DFF, G, bx);
          pg8::EpiSwiglu E{hb, ss + (size_t)(2 * l + 1) * M_ROWS};
          pg8::gemm_phase<pg8::EpiSwiglu, pg8::StaticOrder, true, true>(lds, g, S, E);
#ifdef EXP_G4x2
          gsync(grid); pg8::gemm_phase<pg8::EpiSwiglu, pg8::StaticOrder, true, true>(lds, g, S, E);
#endif
          }
#endif
        gsync(grid);
#if DBG_CUT == 6
        { const KP kp = kargs(); dbg_dump(kp, (const bf16_t*)(GP(unsigned char, 19) + WS_PROJ), (const bf16_t*)(GP(unsigned char, 19) + WS_PROJ) + 16777216); return; }
#endif
#ifndef NO_PH_GEMM5
        { PHASE_PTRS pg8::Gemm g{hb, (const bf16_t*)(wl + W_D), NREAL, DM, DFF}; pg8::StaticOrder S; S.init(NREAL, DM, G, bx);
          pg8::EpiResid E{xb, ss + (size_t)(2 * l + 2) * M_ROWS};
          pg8::gemm_phase<pg8::EpiResid, pg8::StaticOrder, true, true>(lds, g, S, E);
          TailResid TE{xb, ss + (size_t)(2 * l + 2) * M_ROWS}; tail_gemm(lds, hb, (const bf16_t*)(wl + W_D), DFF, TE);
          if (l == 0) touch_weights(lds, wl + W_LAYER, 17 * MiB, G, bx); }
#endif
        gsync(grid);
    }
    { const int l = 0; PHASE_PTRS const float* ssf = ss + (size_t)4 * M_ROWS; const int gt = bx * 512 + ltid(), NT = G * 512;
      for (int i0 = gt; i0 < (NREAL + 128) * 256; i0 += 4 * NT) { u32x2 v[4]; float sv[4]; float* dst[4]; int c4s[4];
#pragma unroll
          for (int u = 0; u < 4; ++u) { const int i = i0 + u * NT; dst[u] = nullptr; if (i < (NREAL + 128) * 256) { int row = i >> 8; const int c4 = (i & 255) * 4; c4s[u] = c4;
              if (row < NREAL) dst[u] = GP(float, 18) + (size_t)row * DM + c4;
              else { const int s = row - NREAL; row = NPROMPT + s; dst[u] = GP(float, 18) + O_YS + (size_t)s * DM + c4; }
              v[u] = __builtin_nontemporal_load((const u32x2*)(xb + (size_t)row * DM + c4)); sv[u] = ssf[row]; } }
#pragma unroll
          for (int u = 0; u < 4; ++u) if (dst[u]) { const float rs = rsqrtf(sv[u] * (1.f / DM) + EPS); const f32x4 fn = *(const f32x4*)(GP(const float, 17) + c4s[u]);
              const f32x4 x = {bflo(v[u].x), bfhi(v[u].x), bflo(v[u].y), bfhi(v[u].y)}; __builtin_nontemporal_store(x * rs * fn, (f32x4*)dst[u]); } } }
}

extern "C" void kernel_launch(void* const* d_in, const int* in_sizes, int n_in, void* d_out, int out_size, void* d_ws, size_t ws_size, hipStream_t stream) {
    static int grid = 0;
    if (grid == 0) {
        if (n_in != 18 || ws_size < WS_END) { fprintf(stderr, "kernel_launch: expected 18 inputs and >= %zu bytes of workspace (got %d, %zu)\n", (size_t)WS_END, n_in, ws_size); grid = -1; return; }
        int dev = 0, cus = 0, per_cu = 0;
        if (hipGetDevice(&dev) != hipSuccess || hipDeviceGetAttribute(&cus, hipDeviceAttributeMultiprocessorCount, dev) != hipSuccess) { grid = -1; return; }
        if (hipFuncSetAttribute((const void*)fwd_kernel, hipFuncAttributeMaxDynamicSharedMemorySize, LDS_BYTES) != hipSuccess) { fprintf(stderr, "kernel_launch: hipFuncSetAttribute failed\n"); grid = -1; return; }
        if (hipOccupancyMaxActiveBlocksPerMultiprocessor(&per_cu, (const void*)fwd_kernel, 512, LDS_BYTES) != hipSuccess || per_cu < 1) { fprintf(stderr, "kernel_launch: occupancy query gave %d\n", per_cu); per_cu = 1; }
        (void)hipGetLastError();
        grid = cus;
    }
    if (grid < 0) return;
    Args a{};
    a.x_prompt = (const float*)d_in[0]; a.x_sample = (const float*)d_in[1]; a.state_conv = (const float*)d_in[2]; a.state_gla = (const float*)d_in[3]; a.meta = (const float*)d_in[4];
    a.w_in = (const float*)d_in[5]; a.conv_w = (const float*)d_in[6]; a.w_gk2 = (const float*)d_in[7]; a.b_gk2 = (const float*)d_in[8]; a.gla_gain = (const float*)d_in[9];
    a.w_a = (const float*)d_in[10]; a.w_b = (const float*)d_in[11]; a.w_o = (const float*)d_in[12]; a.norm_mix = (const float*)d_in[13]; a.norm_ffn = (const float*)d_in[14];
    a.w_gu = (const float*)d_in[15]; a.w_down = (const float*)d_in[16]; a.final_norm = (const float*)d_in[17];
    a.out = (float*)d_out; a.ws = (unsigned char*)d_ws;
    void* args[] = {&a};
    hipError_t e = hipLaunchCooperativeKernel((const void*)fwd_kernel, dim3(grid), dim3(512), args, LDS_BYTES, stream);
    if (e != hipSuccess) fprintf(stderr, "kernel_launch: cooperative launch failed: %s (grid %d)\n", hipGetErrorString(e), grid);
}
```

```cpp
#include <hip/hip_runtime.h>
#include <hip/hip_cooperative_groups.h>
#include <cstdio>
#include <cstdint>
namespace cg = cooperative_groups;
namespace pg8 {
#define PG8_LAS __attribute__((address_space(3)))
typedef unsigned short bf16_t;
typedef short bf16x8 __attribute__((ext_vector_type(8)));
typedef float f32x4 __attribute__((ext_vector_type(4)));
typedef unsigned u32x4 __attribute__((ext_vector_type(4)));
constexpr int BM = 256, BK = 64, HALF = 128, HTB = HALF * BK * 2  , STAGE_BYTES = 8 * HTB, NXCD = 8, WGM = 8;

__host__ __device__ __forceinline__ int lds_byte(int r, int c) { const int st = (r >> 4) * 2 + (c >> 5), rr = r & 15, cc = c & 31, ob = rr * 64 + cc * 2; return st * 1024 + (ob ^ (((ob >> 9) & 1) << 5)); }
__host__ __device__ __forceinline__ void stage_rc(int b, int& R, int& C) { const int st = b / 1024, sb = b % 1024, swz = sb ^ (((sb >> 9) & 1) << 5); R = (st >> 1) * 16 + swz / 64; C = (st & 1) * 32 + (swz % 64) / 2; }
__host__ __device__ __forceinline__ int perm32(int rho) { const int n = rho >> 4, i = rho & 15; return 8 * (i >> 2) + 4 * n + (i & 3); }

struct Unit { int pm, pn, seg; };
struct Gemm { const bf16_t* A; const bf16_t* Bt; int M, N, K; const bf16_t* A2 = nullptr; const bf16_t* Bt2 = nullptr; };

struct StaticOrder {
    int nM, nN, nwg, G, c;
    __host__ __device__ void init(int M, int N, int G_, int c_) { nM = M / BM; nN = N / BM; nwg = nM * nN; G = G_; c = c_; }
    __host__ __device__ bool next(int i, Unit& u) const {
        const long L = (long)i * G + c; if (L >= nwg) return false;
        int wgid = (int)L; { const int q = nwg / NXCD, r = nwg % NXCD, xcd = wgid % NXCD, off = wgid / NXCD; wgid = (xcd < r ? xcd * (q + 1) : r * (q + 1) + (xcd - r) * q) + off; }
        const int nig = WGM * nN, gid = wgid / nig, fm = gid * WGM, gsz = (nM - fm) < WGM ? (nM - fm) : WGM;
        u.pm = fm + ((wgid % nig) % gsz); u.pn = (wgid % nig) / gsz; u.seg = 0; return true;
    }
    __device__ __forceinline__ void a_ready(const Unit&) const {}
    __device__ __forceinline__ void done(const Unit&) const {}
};

__device__ __forceinline__ unsigned cvt_pk_bf16(float lo, float hi) { unsigned r; asm volatile("v_cvt_pk_bf16_f32 %0, %1, %2" : "=v"(r) : "v"(lo), "v"(hi)); return r; }
typedef float f32x2 __attribute__((ext_vector_type(2)));
}
constexpr int M_ROWS = 16640, NREAL = 16384, NPROMPT = 16512, DM = 1024, DFF = 2816, NPROJ = 8192, NGEMM1 = 8704;
constexpr float EPS = 1e-6f;
constexpr int C_GB = 0, C_GC = 1024, C_H = 2048, C_Q = 3072, C_K = 3584, C_V = 4096, C_OG = 5120, C_GA = 6144, C_GBB = 7168;

#define LAS __attribute__((address_space(3)))
#define GP(T, i) ((T*)(__attribute__((address_space(1))) T*)kp[i])
typedef unsigned short bf16_t;
typedef short bf16x8 __attribute__((ext_vector_type(8)));
typedef float f32x4 __attribute__((ext_vector_type(4)));
typedef unsigned u32x4 __attribute__((ext_vector_type(4)));
typedef unsigned u32x2 __attribute__((ext_vector_type(2)));

typedef __bf16 bf16v2_t __attribute__((ext_vector_type(2)));
typedef float f32v2_t __attribute__((ext_vector_type(2)));
__device__ __forceinline__ unsigned pk_bf16(float lo, float hi) { const f32v2_t v = {lo, hi}; const bf16v2_t b = __builtin_convertvector(v, bf16v2_t); return __builtin_bit_cast(unsigned, b); }
__device__ __forceinline__ float bflo(unsigned w) { return __uint_as_float(w << 16); }
__device__ __forceinline__ float bfhi(unsigned w) { return __uint_as_float(w & 0xffff0000u); }
__device__ __forceinline__ float bf2f(bf16_t h) { return __uint_as_float((unsigned)h << 16); }
__device__ __forceinline__ bf16_t f2bf(float f) { return (bf16_t)(pk_bf16(f, 0.f) & 0xffffu); }
__device__ __forceinline__ float sigm(float x) { return __builtin_amdgcn_rcpf(1.f + __expf(-x)); }
__device__ __forceinline__ float silu(float x) { return x * __builtin_amdgcn_rcpf(1.f + __expf(-x)); }
__device__ __forceinline__ float logsig(float x) { return fminf(x, 0.f) - __logf(1.f + __expf(-fabsf(x))); }
__device__ __forceinline__ int ltid() { int t = threadIdx.x; asm volatile("" : "+v"(t)); return t; }
__device__ __forceinline__ float* xrow(float* dout, float* xtail, int row) { return row < NREAL ? dout + (size_t)row * DM : xtail + (size_t)(row - NREAL) * DM; }

namespace pg8 {
struct EpiProj { static constexpr bool IDEMPOTENT = true;
    static constexpr bool PERM = true, AFTER_DRAIN = false;
    bf16_t* proj; float* gk; const float* ss; const float* bgk;
    __device__ __forceinline__ void operator()(const f32x4 (&acc)[2][2][4][2], const Unit& u, int wr, int wc, int fr, int fq) const {
        const int row0 = u.pm * BM + wr * 64 + fr, cw = wc * 32 + 8 * fq;
        float rsv[2][4];
#pragma unroll
        for (int ai = 0; ai < 2; ++ai)
#pragma unroll
            for (int m = 0; m < 4; ++m) rsv[ai][m] = ss[row0 + ai * HALF + m * 16];
        asm volatile("" ::: "memory");
        if (u.pn < 32) {
#pragma unroll
            for (int ai = 0; ai < 2; ++ai)
#pragma unroll
                for (int m = 0; m < 4; ++m) { const int row = row0 + ai * HALF + m * 16; const float rs = rsqrtf(rsv[ai][m] * (1.f / DM) + EPS);
                    bf16_t* rp = proj + (size_t)row * NPROJ + u.pn * BM + cw;
#pragma unroll
                    for (int bj = 0; bj < 2; ++bj) { const f32x4 v0 = acc[ai][bj][m][0] * rs, v1 = acc[ai][bj][m][1] * rs; u32x4 w;
                        w.x = pk_bf16(v0[0], v0[1]); w.y = pk_bf16(v0[2], v0[3]); w.z = pk_bf16(v1[0], v1[1]); w.w = pk_bf16(v1[2], v1[3]); *(u32x4*)(rp + bj * HALF) = w; } }
        } else {
            const int cg0 = (u.pn - 32) * BM + cw;
#pragma unroll
            for (int bj = 0; bj < 2; ++bj) { const f32x4 b0 = *(const f32x4*)(bgk + cg0 + bj * HALF), b1 = *(const f32x4*)(bgk + cg0 + bj * HALF + 4);
#pragma unroll
                for (int ai = 0; ai < 2; ++ai)
#pragma unroll
                    for (int m = 0; m < 4; ++m) { const int row = row0 + ai * HALF + m * 16; const float rs = rsqrtf(rsv[ai][m] * (1.f / DM) + EPS);
                        f32x4 v0 = acc[ai][bj][m][0] * rs + b0, v1 = acc[ai][bj][m][1] * rs + b1;
#pragma unroll
                        for (int e = 0; e < 4; ++e) { v0[e] = logsig(v0[e]) * 0.0625f; v1[e] = logsig(v1[e]) * 0.0625f; }
                        float* gp = gk + (size_t)row * 512 + cg0 + bj * HALF; *(f32x4*)gp = v0; *(f32x4*)(gp + 4) = v1; } }
        }
    }
};
template <bool ADD> struct EpiGate { static constexpr bool IDEMPOTENT = false;
    static constexpr bool PERM = true, AFTER_DRAIN = false;
    const bf16_t* gate; bf16_t* mb;
    __device__ __forceinline__ void operator()(const f32x4 (&acc)[2][2][4][2], const Unit& u, int wr, int wc, int fr, int fq) const {
        const int row0 = u.pm * BM + wr * 64 + fr, col0 = u.pn * BM + wc * 32 + 8 * fq;
#pragma unroll
        for (int am = 0; am < 4; ++am) { const int ai = am >> 1, mb0 = (am & 1) * 2;
            u32x4 gv[4][2], ov[4][2];
#pragma unroll
            for (int m = mb0; m < mb0 + 2; ++m)
#pragma unroll
                for (int bj = 0; bj < 2; ++bj) { const int row = row0 + ai * HALF + m * 16; gv[m][bj] = __builtin_nontemporal_load((const u32x4*)(gate + (size_t)row * NPROJ + col0 + bj * HALF));
                    if (ADD) ov[m][bj] = *(const u32x4*)(mb + (size_t)row * DM + col0 + bj * HALF); }
            asm volatile("" ::: "memory");
#pragma unroll
            for (int m = mb0; m < mb0 + 2; ++m)
#pragma unroll
                for (int bj = 0; bj < 2; ++bj) { const int row = row0 + ai * HALF + m * 16; const u32x4 g = gv[m][bj]; bf16_t* op = mb + (size_t)row * DM + col0 + bj * HALF;
                    const f32x4 a0 = acc[ai][bj][m][0], a1 = acc[ai][bj][m][1];
                    float r0 = sigm(bflo(g.x)) * a0[0], r1 = sigm(bfhi(g.x)) * a0[1], r2 = sigm(bflo(g.y)) * a0[2], r3 = sigm(bfhi(g.y)) * a0[3];
                    float r4 = sigm(bflo(g.z)) * a1[0], r5 = sigm(bfhi(g.z)) * a1[1], r6 = sigm(bflo(g.w)) * a1[2], r7 = sigm(bfhi(g.w)) * a1[3];
                    if (ADD) { const u32x4 o = ov[m][bj]; r0 += bflo(o.x); r1 += bfhi(o.x); r2 += bflo(o.y); r3 += bfhi(o.y); r4 += bflo(o.z); r5 += bfhi(o.z); r6 += bflo(o.w); r7 += bfhi(o.w); }
                    u32x4 w; w.x = pk_bf16(r0, r1); w.y = pk_bf16(r2, r3); w.z = pk_bf16(r4, r5); w.w = pk_bf16(r6, r7); *(u32x4*)op = w; }
        }
    }
};
struct PairOrder : StaticOrder {
    __host__ __device__ bool next(int i, Unit& u) const { if (!StaticOrder::next(i >> 1, u)) return false; u.seg = i & 1; return true; }
};
struct EpiGate2 { static constexpr bool IDEMPOTENT = false;
    static constexpr bool PERM = true, AFTER_DRAIN = false;
    const bf16_t* gateA; const bf16_t* gateB; bf16_t* mb;
    __device__ __forceinline__ void operator()(const f32x4 (&acc)[2][2][4][2], const Unit& u, int wr, int wc, int fr, int fq) const {
        if (u.seg == 0) { EpiGate<false> e{gateA, mb}; e(acc, u, wr, wc, fr, fq); } else { EpiGate<true> e{gateB, mb}; e(acc, u, wr, wc, fr, fq); }
    }
};
struct EpiResid { static constexpr bool IDEMPOTENT = false;
    static constexpr bool PERM = true, AFTER_DRAIN = false;
    bf16_t* xb; float* ssn;
    __device__ __forceinline__ void operator()(const f32x4 (&acc)[2][2][4][2], const Unit& u, int wr, int wc, int fr, int fq) const {
        const int row0 = u.pm * BM + wr * 64 + fr, col0 = u.pn * BM + wc * 32 + 8 * fq;
#pragma unroll
        for (int ai = 0; ai < 2; ++ai) {
            u32x4 xv[4][2];
#pragma unroll
            for (int m = 0; m < 4; ++m)
#pragma unroll
                for (int bj = 0; bj < 2; ++bj) xv[m][bj] = *(const u32x4*)(xb + (size_t)(row0 + ai * HALF + m * 16) * DM + col0 + bj * HALF);
            asm volatile("" ::: "memory");
#pragma unroll
            for (int m = 0; m < 4; ++m) { const int row = row0 + ai * HALF + m * 16; bf16_t* bp = xb + (size_t)row * DM + col0; float s = 0.f;
#pragma unroll
                for (int bj = 0; bj < 2; ++bj) { const u32x4 o = xv[m][bj]; const f32x4 a0 = acc[ai][bj][m][0], a1 = acc[ai][bj][m][1];
                    u32x4 w; w.x = pk_bf16(bflo(o.x) + a0[0], bfhi(o.x) + a0[1]); w.y = pk_bf16(bflo(o.y) + a0[2], bfhi(o.y) + a0[3]);
                    w.z = pk_bf16(bflo(o.z) + a1[0], bfhi(o.z) + a1[1]); w.w = pk_bf16(bflo(o.w) + a1[2], bfhi(o.w) + a1[3]); *(u32x4*)(bp + bj * HALF) = w;
                    const float r0 = bflo(w.x), r1 = bfhi(w.x), r2 = bflo(w.y), r3 = bfhi(w.y), r4 = bflo(w.z), r5 = bfhi(w.z), r6 = bflo(w.w), r7 = bfhi(w.w);
                    s += (r0 * r0 + r1 * r1) + (r2 * r2 + r3 * r3) + (r4 * r4 + r5 * r5) + (r6 * r6 + r7 * r7); }
                s += __shfl_xor(s, 16); s += __shfl_xor(s, 32);
                if (fq == 0) atomicAdd(ssn + row, s); }
        }
    }
};
struct EpiSwiglu { static constexpr bool IDEMPOTENT = true;
    static constexpr bool PERM = true, AFTER_DRAIN = false;
    bf16_t* hb; const float* ss;
    __device__ __forceinline__ void operator()(const f32x4 (&acc)[2][2][4][2], const Unit& u, int wr, int wc, int fr, int fq) const {
        const int row0 = u.pm * BM + wr * 64 + fr, col0 = u.pn * HALF + wc * 32 + 8 * fq;
        float rsv[2][4];
#pragma unroll
        for (int ai = 0; ai < 2; ++ai)
#pragma unroll
            for (int m = 0; m < 4; ++m) rsv[ai][m] = ss[row0 + ai * HALF + m * 16];
        asm volatile("" ::: "memory");
#pragma unroll
        for (int ai = 0; ai < 2; ++ai)
#pragma unroll
            for (int m = 0; m < 4; ++m) { const int row = row0 + ai * HALF + m * 16; const float rs = rsqrtf(rsv[ai][m] * (1.f / DM) + EPS);
                const f32x4 g0 = acc[ai][0][m][0] * rs, g1 = acc[ai][0][m][1] * rs, u0 = acc[ai][1][m][0] * rs, u1 = acc[ai][1][m][1] * rs;
                u32x4 w; w.x = pk_bf16(silu(g0[0]) * u0[0], silu(g0[1]) * u0[1]); w.y = pk_bf16(silu(g0[2]) * u0[2], silu(g0[3]) * u0[3]);
                w.z = pk_bf16(silu(g1[0]) * u1[0], silu(g1[1]) * u1[1]); w.w = pk_bf16(silu(g1[2]) * u1[2], silu(g1[3]) * u1[3]);
                *(u32x4*)(hb + (size_t)row * DFF + col0) = w; }
    }
};
}
namespace pg8 {
template <class Epi, class Sched, bool ALIGN_EPI = false, bool SP2 = false>
__device__ __forceinline__ void gemm_phase(PG8_LAS unsigned char* lds, const Gemm g, const Sched& S, const Epi& E) {
    const int tid = ltid(), wid = __builtin_amdgcn_readfirstlane(tid >> 6), lane = tid & 63, wr = wid >> 2, wc = wid & 3, fr = lane & 15, fq = lane >> 4;
    const int K = g.K, nt = K / BK;
    unsigned voffA[2], voffB[2];
#pragma unroll
    for (int i = 0; i < 2; ++i) { int R, C; stage_rc(tid * 16 + i * 8192, R, C); const int Rb = Epi::PERM ? ((R & ~31) + perm32(R & 31)) : R;
        voffA[i] = (unsigned)(R * K + C) * 2u; voffB[i] = (unsigned)(Rb * K + C) * 2u; }
    const size_t kstep = (size_t)(BK * 2);
    const size_t hstep = (size_t)HALF * K * 2;
    const size_t tstep = 2 * hstep;
    const unsigned ldsw = (unsigned)wid * 1024u;
    const int aoff = lds_byte(wr * 64 + fr, fq * 8), boff = lds_byte(wc * 32 + fr, fq * 8);
#define PG8_SA(b, h) (((b) * 2 + (h)) * HTB)
#define PG8_SB(b, h) ((4 + (b) * 2 + (h)) * HTB)
#define PG8_STAGE(bufoff, gbase, voff) do { _Pragma("unroll") for (int _i = 0; _i < 2; ++_i) \
        __builtin_amdgcn_global_load_lds((const unsigned*)((const char*)(gbase) + (voff)[_i]), (PG8_LAS unsigned*)(lds + (bufoff) + ldsw + _i * 8192), 16, 0, 0); } while (0)
#define PG8_LDA(dst, b, h) do { _Pragma("unroll") for (int m = 0; m < 4; ++m) _Pragma("unroll") for (int k = 0; k < 2; ++k) dst[m][k] = *(const PG8_LAS bf16x8*)(lds + PG8_SA(b, h) + aoff + m * 2048 + k * 1024); } while (0)
#define PG8_LDB(dst, b, h) do { _Pragma("unroll") for (int n = 0; n < 2; ++n) _Pragma("unroll") for (int k = 0; k < 2; ++k) dst[n][k] = *(const PG8_LAS bf16x8*)(lds + PG8_SB(b, h) + boff + n * 2048 + k * 1024); } while (0)
#define PG8_MMA(ai, bj, At, Bt) do { __builtin_amdgcn_s_setprio(1); _Pragma("unroll") for (int m = 0; m < 4; ++m) _Pragma("unroll") for (int n = 0; n < 2; ++n) _Pragma("unroll") for (int k = 0; k < 2; ++k) \
        acc[ai][bj][m][n] = __builtin_amdgcn_mfma_f32_16x16x32_bf16(Bt[n][k], At[m][k], acc[ai][bj][m][n], 0, 0, 0); __builtin_amdgcn_s_setprio(0); } while (0)
#define PG8_WAIT_V(n) asm volatile("s_waitcnt vmcnt(" #n ")" ::: "memory")
#define PG8_WAIT_L(n) asm volatile("s_waitcnt lgkmcnt(" #n ")" ::: "memory")
#define PG8_BAR __builtin_amdgcn_s_barrier()
#define PG8_SCHED __builtin_amdgcn_sched_barrier(0)
    Unit cur, nxt; int ui = 0;
    if (!S.next(0, cur)) return;
    f32x4 acc[2][2][4][2];
#pragma unroll
    for (int a = 0; a < 2; ++a)
#pragma unroll
        for (int b = 0; b < 2; ++b)
#pragma unroll
            for (int m = 0; m < 4; ++m)
#pragma unroll
                for (int n = 0; n < 2; ++n) acc[a][b][m][n] = (f32x4){0.f, 0.f, 0.f, 0.f};
    bf16x8 At[4][2], B0[2][2], B1[2][2];
    const char* cA = (const char*)(cur.seg ? g.A2 : g.A) + (size_t)cur.pm * tstep; const char* cB = (const char*)(cur.seg ? g.Bt2 : g.Bt) + (size_t)cur.pn * tstep;
    S.a_ready(cur);
    if constexpr (SP2) {
        PG8_STAGE(PG8_SB(0, 0), cB, voffB); PG8_STAGE(PG8_SB(0, 1), cB + hstep, voffB); PG8_STAGE(PG8_SA(0, 0), cA, voffA); PG8_STAGE(PG8_SA(0, 1), cA + hstep, voffA);
        if (wr == 1) PG8_BAR;
        PG8_WAIT_V(2); PG8_BAR;
        PG8_STAGE(PG8_SB(1, 0), cB + kstep, voffB); PG8_STAGE(PG8_SA(1, 0), cA + kstep, voffA); PG8_STAGE(PG8_SB(1, 1), cB + hstep + kstep, voffB);
        PG8_WAIT_V(6); PG8_BAR;
    } else {
        PG8_STAGE(PG8_SB(0, 0), cB, voffB); PG8_STAGE(PG8_SA(0, 0), cA, voffA); PG8_STAGE(PG8_SB(0, 1), cB + hstep, voffB); PG8_STAGE(PG8_SA(0, 1), cA + hstep, voffA);
        if (wr == 1) PG8_BAR;
        PG8_WAIT_V(4); PG8_BAR;
        PG8_STAGE(PG8_SB(1, 0), cB + kstep, voffB); PG8_STAGE(PG8_SA(1, 0), cA + kstep, voffA); PG8_STAGE(PG8_SB(1, 1), cB + hstep + kstep, voffB);
        PG8_WAIT_V(6); PG8_BAR;
    }
    for (;;) {
        const bool has_next = S.next(ui + 1, nxt);
        const char* nA = has_next ? (const char*)(nxt.seg ? g.A2 : g.A) + (size_t)nxt.pm * tstep : cA; const char* nB = has_next ? (const char*)(nxt.seg ? g.Bt2 : g.Bt) + (size_t)nxt.pn * tstep : cB;
        for (int t = 0; t < nt; t += 2) {
            const bool last = (t == nt - 2);
            const char* a1 = cA + (size_t)(t + 1) * kstep;
            const char* a2 = last ? nA : cA + (size_t)(t + 2) * kstep; const char* b2 = last ? nB : cB + (size_t)(t + 2) * kstep;
            const char* a3 = a2 + kstep; const char* b3 = b2 + kstep;
            if (last && has_next) S.a_ready(nxt);
            if constexpr (SP2) {
            PG8_LDB(B0, 0, 0); PG8_LDB(B1, 0, 1); PG8_SCHED; PG8_LDA(At, 0, 0); PG8_STAGE(PG8_SA(1, 1), a1 + hstep, voffA);
            PG8_WAIT_V(8); PG8_WAIT_L(0); PG8_BAR; PG8_MMA(0, 0, At, B0); PG8_MMA(0, 1, At, B1); PG8_BAR; PG8_SCHED;
            PG8_LDA(At, 0, 1); PG8_STAGE(PG8_SB(0, 0), b2, voffB); PG8_STAGE(PG8_SB(0, 1), b2 + hstep, voffB); PG8_STAGE(PG8_SA(0, 0), a2, voffA);
            PG8_WAIT_V(8); PG8_WAIT_L(0); PG8_BAR; PG8_MMA(1, 0, At, B0); PG8_MMA(1, 1, At, B1); PG8_BAR; PG8_SCHED;
            PG8_LDB(B0, 1, 0); PG8_LDB(B1, 1, 1); PG8_SCHED; PG8_LDA(At, 1, 0); PG8_STAGE(PG8_SA(0, 1), a2 + hstep, voffA);
            PG8_WAIT_V(8); PG8_WAIT_L(0); PG8_BAR; PG8_MMA(0, 0, At, B0); PG8_MMA(0, 1, At, B1); PG8_BAR; PG8_SCHED;
            PG8_LDA(At, 1, 1); PG8_STAGE(PG8_SB(1, 0), b3, voffB); PG8_STAGE(PG8_SB(1, 1), b3 + hstep, voffB); PG8_STAGE(PG8_SA(1, 0), a3, voffA);
            PG8_WAIT_V(8); PG8_WAIT_L(0); PG8_BAR; PG8_MMA(1, 0, At, B0); PG8_MMA(1, 1, At, B1); PG8_BAR; PG8_SCHED;
            } else {
            PG8_LDB(B0, 0, 0); PG8_SCHED; PG8_LDA(At, 0, 0); PG8_STAGE(PG8_SA(1, 1), a1 + hstep, voffA);
            PG8_WAIT_L(8); PG8_BAR; PG8_WAIT_L(0); PG8_MMA(0, 0, At, B0); PG8_BAR; PG8_SCHED;
            PG8_LDB(B1, 0, 1); PG8_STAGE(PG8_SB(0, 0), b2, voffB);
            PG8_BAR; PG8_WAIT_L(0); PG8_MMA(0, 1, At, B1); PG8_BAR;
            PG8_LDA(At, 0, 1); PG8_STAGE(PG8_SA(0, 0), a2, voffA);
            PG8_BAR; PG8_WAIT_L(0); PG8_MMA(1, 0, At, B0); PG8_BAR; PG8_SCHED;
            PG8_STAGE(PG8_SB(0, 1), b2 + hstep, voffB);
            PG8_WAIT_V(6); PG8_BAR; PG8_MMA(1, 1, At, B1); PG8_BAR;
            PG8_LDB(B0, 1, 0); PG8_SCHED; PG8_LDA(At, 1, 0); PG8_STAGE(PG8_SA(0, 1), a2 + hstep, voffA);
            PG8_WAIT_L(8); PG8_BAR; PG8_WAIT_L(0); PG8_MMA(0, 0, At, B0); PG8_BAR; PG8_SCHED;
            PG8_LDB(B1, 1, 1); PG8_STAGE(PG8_SB(1, 0), b3, voffB);
            PG8_BAR; PG8_WAIT_L(0); PG8_MMA(0, 1, At, B1); PG8_BAR;
            PG8_LDA(At, 1, 1); PG8_STAGE(PG8_SA(1, 0), a3, voffA);
            PG8_BAR; PG8_WAIT_L(0); PG8_MMA(1, 0, At, B0); PG8_BAR; PG8_SCHED;
            PG8_STAGE(PG8_SB(1, 1), b3 + hstep, voffB);
            PG8_WAIT_V(6); PG8_BAR; PG8_MMA(1, 1, At, B1); PG8_BAR;
            }
        }
        if constexpr (ALIGN_EPI) { if (wr == 0) PG8_BAR; }
        if constexpr (!Epi::AFTER_DRAIN) { E(acc, cur, wr, wc, fr, fq);
#ifdef EXP_EPI2
            if constexpr (Epi::IDEMPOTENT) { asm volatile("" ::: "memory"); E(acc, cur, wr, wc, fr, fq); }
#endif
            S.done(cur); }
        if (!has_next) break;
#pragma unroll
        for (int a = 0; a < 2; ++a)
#pragma unroll
            for (int b = 0; b < 2; ++b)
#pragma unroll
                for (int m = 0; m < 4; ++m)
#pragma unroll
                    for (int n = 0; n < 2; ++n) acc[a][b][m][n] = (f32x4){0.f, 0.f, 0.f, 0.f};
        cur = nxt; cA = nA; cB = nB; ++ui;
        if constexpr (ALIGN_EPI) { if (wr == 1) PG8_BAR; }
    }
    PG8_WAIT_V(0);
    if constexpr (!ALIGN_EPI) { if (wr == 0) PG8_BAR; }
    PG8_BAR;
    if constexpr (Epi::AFTER_DRAIN) { E.fused(acc, cur, wr, wc, fr, fq, lds, wid, lane); S.done(cur); }
#undef PG8_SA
#undef PG8_SB
#undef PG8_STAGE
#undef PG8_LDA
#undef PG8_LDB
#undef PG8_MMA
#undef PG8_WAIT_V
#undef PG8_WAIT_L
#undef PG8_BAR
#undef PG8_SCHED
}
}
constexpr size_t MiB = 1u << 20;
constexpr size_t WS_SS = 0;
constexpr size_t WS_XTAIL = 1 * MiB;
constexpr size_t WS_W = 2 * MiB;
constexpr size_t W_LAYER = 39 * MiB + MiB / 2, W_A = 17 * MiB, W_B = 19 * MiB, W_O = 21 * MiB, W_GU = 23 * MiB, W_D = 34 * MiB;
constexpr size_t WS_XB = 81 * MiB;
constexpr size_t WS_GK = WS_XB + 32 * MiB + MiB / 2;
constexpr size_t WS_AIN = WS_GK + 32 * MiB + MiB / 2;
constexpr size_t WS_BIN = WS_AIN + 32 * MiB + MiB / 2;
constexpr size_t WS_OB = WS_BIN + 32 * MiB + MiB / 2;
constexpr size_t WS_PROJ = WS_OB + 32 * MiB + MiB / 2;
constexpr size_t WS_G0 = WS_PROJ + 260 * MiB;
constexpr size_t WS_END = WS_G0 + 1 * MiB;
constexpr size_t O_YP = 0, O_YS = 16777216, O_PCONV = 16908288, O_PGLA = 16941056, O_SCONV = 19038208, O_SGLA = 19562496;

struct Args {
    const float *x_prompt, *x_sample, *state_conv, *state_gla, *meta, *w_in, *conv_w, *w_gk2, *b_gk2, *gla_gain, *w_a, *w_b, *w_o, *norm_mix, *norm_ffn, *w_gu, *w_down, *final_norm;
    float* out; unsigned char* ws;
};

__device__ __forceinline__ float wave_sum(float v) {
#pragma unroll
    for (int o = 1; o < 64; o <<= 1) v += __shfl_xor(v, o);
    return v;
}

__device__ __forceinline__ void p0_item(const float* W, int ldw, int srccol, const float* rowscale, float cscale, const float* wgk2  , int jcol,
                                        bf16_t* WT, int K, int nrow0, int k0, LAS float* scr, int lane) {
    const int nn = lane & 31;
    if (wgk2 == nullptr) {
        const int kr = lane >> 3, c4 = (lane & 7) * 4;
        f32x4 v[8]; float rs[8];
#pragma unroll
        for (int j = 0; j < 8; ++j) { const int kk = 8 * j + kr; v[j] = __builtin_nontemporal_load((const f32x4*)(W + (size_t)(k0 + kk) * ldw + srccol + c4)); rs[j] = rowscale ? rowscale[k0 + kk] * cscale : cscale; }
#pragma unroll
        for (int j = 0; j < 8; ++j) { const int kk = 8 * j + kr; LAS float* sp = scr + kk * 33 + c4; sp[0] = v[j][0] * rs[j]; sp[1] = v[j][1] * rs[j]; sp[2] = v[j][2] * rs[j]; sp[3] = v[j][3] * rs[j]; }
    } else {
        float g2[16];
#pragma unroll
        for (int r = 0; r < 16; ++r) g2[r] = wgk2[r * 512 + jcol + nn];
#pragma unroll 4
        for (int i = 0; i < 32; ++i) { const int kk = 2 * i + (lane >> 5); const float* zr = W + (size_t)(k0 + kk) * ldw + 6144; float v = 0.f;
#pragma unroll
            for (int r = 0; r < 16; ++r) v += zr[r] * g2[r];
            scr[kk * 33 + nn] = v * rowscale[k0 + kk]; }
    }
    asm volatile("s_waitcnt lgkmcnt(0)" ::: "memory");
    const int c = lane & 7;
#pragma unroll
    for (int j = 0; j < 4; ++j) { const int n = (lane >> 3) + 8 * j; const LAS float* s = scr + (8 * c) * 33 + n;
        u32x4 o; o.x = pk_bf16(s[0 * 33], s[1 * 33]); o.y = pk_bf16(s[2 * 33], s[3 * 33]); o.z = pk_bf16(s[4 * 33], s[5 * 33]); o.w = pk_bf16(s[6 * 33], s[7 * 33]);
        *(u32x4*)(WT + (size_t)(nrow0 + n) * K + k0 + 8 * c) = o; }
    asm volatile("s_waitcnt lgkmcnt(0)" ::: "memory");
}

typedef const __attribute__((address_space(4))) unsigned long long* KP;
__device__ __forceinline__ void p0_prologue(KP kp, LAS unsigned char* lds) {
    const int tid = ltid(), lane = tid & 63, wave = tid >> 6;
    LAS float* scr = (LAS float*)(lds + wave * 16384);
    const int gw = blockIdx.x * 8 + wave, NGW = gridDim.x * 8;
    constexpr int I_1 = 16 * 272, I_S = 16 * 32, I_GU = 16 * 176, I_D = 44 * 32, I_L = I_1 + 3 * I_S + I_GU + I_D;
    for (int it = gw; it < 2 * I_L; it += NGW) {
        const int l = it / I_L; int r = it % I_L;
        unsigned char* wl = GP(unsigned char, 19) + WS_W + (size_t)l * W_LAYER;
        if (r < I_1) { const int kb = r / 272, nb = r % 272, n0 = nb * 32; const float* W = GP(const float, 5) + (size_t)l * 1024 * 8208; const float* nm = GP(const float, 13) + l * 1024;
            if (n0 < 8192) { const int src = n0 < 6144 ? n0 : n0 + 16; const float cs = (n0 >= C_Q && n0 < C_K) ? 0.08838834764831845f : 1.f;
                p0_item(W, 8208, src, nm, cs, nullptr, 0, (bf16_t*)wl, 1024, n0, kb * 64, scr, lane); }
            else p0_item(W, 8208, 0, nm, 1.f, GP(const float, 7) + (size_t)l * 16 * 512, n0 - 8192, (bf16_t*)wl, 1024, n0, kb * 64, scr, lane);
            continue; }
        r -= I_1;
        if (r < 3 * I_S) { const int which = r / I_S; r %= I_S; const int kb = r / 32, nb = r % 32;
            const float* W = GP(const float, 10 + which) + (size_t)l * 1024 * 1024;
            p0_item(W, 1024, nb * 32, nullptr, 1.f, nullptr, 0, (bf16_t*)(wl + W_A + (size_t)which * 2 * MiB), 1024, nb * 32, kb * 64, scr, lane); continue; }
        r -= 3 * I_S;
        if (r < I_GU) { const int kb = r / 176, nb = r % 176, n0 = nb * 32;
            const int pn = n0 >> 8, bj = (n0 >> 7) & 1, j = n0 & 127;
            p0_item(GP(const float, 15) + (size_t)l * 1024 * 5632, 5632, bj * DFF + 128 * pn + j, GP(const float, 14) + l * 1024, 1.f, nullptr, 0, (bf16_t*)(wl + W_GU), 1024, n0, kb * 64, scr, lane); continue; }
        r -= I_GU;
        { const int kb = r / 32, nb = r % 32; p0_item(GP(const float, 16) + (size_t)l * DFF * 1024, 1024, nb * 32, nullptr, 1.f, nullptr, 0, (bf16_t*)(wl + W_D), DFF, nb * 32, kb * 64, scr, lane); }
    }
    float* ss = (float*)(GP(unsigned char, 19) + WS_SS); bf16_t* xb = (bf16_t*)(GP(unsigned char, 19) + WS_XB);
    for (int row0 = gw; row0 < M_ROWS; row0 += 2 * NGW) { f32x4 v[2][4]; int rows[2];
#pragma unroll
        for (int u = 0; u < 2; ++u) { const int row = row0 + u * NGW; rows[u] = row < M_ROWS ? row : -1;
            if (rows[u] >= 0) { const float* src = row < NREAL ? GP(const float, 0) + (size_t)row * DM : row < NPROMPT ? GP(const float, 4) + (size_t)((row - NREAL) & 15) * DM : GP(const float, 1) + (size_t)(row - NPROMPT) * DM;
#pragma unroll
                for (int j = 0; j < 4; ++j) v[u][j] = __builtin_nontemporal_load((const f32x4*)src + lane + 64 * j); } }
#pragma unroll
        for (int u = 0; u < 2; ++u) if (rows[u] >= 0) { float s = 0.f;
#pragma unroll
            for (int j = 0; j < 4; ++j) { u32x2 w; w.x = pk_bf16(v[u][j][0], v[u][j][1]); w.y = pk_bf16(v[u][j][2], v[u][j][3]); *((u32x2*)(xb + (size_t)rows[u] * DM) + lane + 64 * j) = w;
                const float r0 = bflo(w.x), r1 = bfhi(w.x), r2 = bflo(w.y), r3 = bfhi(w.y); s += (r0 * r0 + r1 * r1) + (r2 * r2 + r3 * r3); }
            s = wave_sum(s); if (lane == 0) ss[rows[u]] = s; } }
    { const int gt = blockIdx.x * 512 + tid, NT = gridDim.x * 512;
      for (int i = gt; i < 4 * M_ROWS + 8 * M_ROWS; i += NT) ss[M_ROWS + i] = 0.f; }
}

constexpr int QS = 136, VS_ = 72;
#ifdef DBG_GLA_DBLBAR
#define GLA_SYNC() do { __syncthreads(); asm volatile("s_waitcnt vmcnt(0) lgkmcnt(0)" ::: "memory"); __syncthreads(); } while (0)
#else
#define GLA_SYNC() __syncthreads()
#endif
__device__ __forceinline__ void gla_prompt_item(LAS unsigned char* lds, int item, const bf16_t* proj, const float* gkb, bf16_t* obuf, float* ossq, float* pgla, bool do_atomic = true) {
    const int tid = ltid(), lane = tid & 63, w = __builtin_amdgcn_readfirstlane(tid >> 6), fr = lane & 15, fq = lane >> 4;
    const int b = item >> 4, h = (item >> 2) & 3, vs = item & 3;
    LAS bf16_t* QT = (LAS bf16_t*)lds;
    LAS bf16_t* KT = (LAS bf16_t*)(lds + 17408);
    LAS float*  GK = (LAS float*)(lds + 34816);
    LAS bf16_t* KH = (LAS bf16_t*)(lds + 67584);
    LAS bf16_t* VT = (LAS bf16_t*)(lds + 86016);
    LAS bf16_t* AM = (LAS bf16_t*)(lds + 95232);
    LAS bf16_t* ST = (LAS bf16_t*)(lds + 104448);
    LAS float*  PT = (LAS float*)(lds + 121856);
    LAS float*  DC = (LAS float*)(lds + 125952);
    GLA_SYNC();
    for (int i = tid; i < 64 * QS / 2; i += 512) ((LAS unsigned*)ST)[i] = 0u;
    f32x4 sacc[4];
#pragma unroll
    for (int x = 0; x < 4; ++x) sacc[x] = (f32x4){0.f, 0.f, 0.f, 0.f};
    u32x4 rq[2], rk[2], rv, rg[4];
    u32x2 ow0 = {0u, 0u}, ow1 = {0u, 0u}; float osq = 0.f; int orow = -1;
    const int qt0 = tid >> 4, qc = tid & 15, vt = tid >> 3, vc = tid & 7, gt0 = tid >> 5, gc = tid & 31;
#define GLA_FLUSH() do { if (orow >= 0) { bf16_t* op_ = obuf + (size_t)orow * DM + h * 256 + vs * 64 + 32 * (w & 1) + 4 * fq; *(u32x2*)op_ = ow0; *(u32x2*)(op_ + 16) = ow1; \
        float s_ = osq; s_ += __shfl_xor(s_, 16); s_ += __shfl_xor(s_, 32); if (fq == 0 && do_atomic) __hip_atomic_fetch_add((__attribute__((address_space(1))) float*)(ossq + (size_t)orow * 4 + h), s_, __ATOMIC_RELAXED, __HIP_MEMORY_SCOPE_AGENT); } \
        else { float s_ = osq; s_ += __shfl_xor(s_, 16); s_ += __shfl_xor(s_, 32); (void)s_; } } while (0)
#define GLA_ROW(c, t) ((c) == 0 ? NREAL + b * 16 + (t) : b * 2048 + ((c) - 1) * 64 + (t))
#define GLA_PREFETCH(c) do { const int nv = (c) == 0 ? 16 : 64; const u32x4 z4 = {0u, 0u, 0u, 0u}; \
        _Pragma("unroll") for (int i = 0; i < 2; ++i) { const int t = qt0 + 32 * i; const bf16_t* p = proj + (size_t)GLA_ROW(c, t) * NPROJ + h * 128 + qc * 8; \
            rq[i] = t < nv ? *(const u32x4*)(p + C_Q) : z4; rk[i] = t < nv ? *(const u32x4*)(p + C_K) : z4; } \
        rv = vt < nv ? *(const u32x4*)(proj + (size_t)GLA_ROW(c, vt) * NPROJ + C_V + h * 256 + vs * 64 + vc * 8) : z4; \
        _Pragma("unroll") for (int i = 0; i < 4; ++i) { const int t = gt0 + 16 * i; rg[i] = t < nv ? *(const u32x4*)(gkb + (size_t)GLA_ROW(c, t) * 512 + h * 128 + gc * 4) : z4; } } while (0)
#ifndef DBG_GLA_SYNCLOAD
    GLA_PREFETCH(0);
#endif
    for (int c = 0; c < 33; ++c) {
#ifdef DBG_GLA_SYNCLOAD
        GLA_PREFETCH(c);
#endif
#pragma unroll
        for (int i = 0; i < 2; ++i) { const int t = qt0 + 32 * i; *(LAS u32x4*)(QT + t * QS + qc * 8) = rq[i]; *(LAS u32x4*)(KT + t * QS + qc * 8) = rk[i]; }
#pragma unroll
        for (int i = 0; i < 4; ++i) { const int t = gt0 + 16 * i; *(LAS u32x4*)(GK + t * 128 + gc * 4) = rg[i]; }
        { LAS bf16_t* vp = VT + (vc * 8) * VS_ + vt;
          vp[0 * VS_] = (bf16_t)(rv.x & 0xffffu); vp[1 * VS_] = (bf16_t)(rv.x >> 16); vp[2 * VS_] = (bf16_t)(rv.y & 0xffffu); vp[3 * VS_] = (bf16_t)(rv.y >> 16);
          vp[4 * VS_] = (bf16_t)(rv.z & 0xffffu); vp[5 * VS_] = (bf16_t)(rv.z >> 16); vp[6 * VS_] = (bf16_t)(rv.w & 0xffffu); vp[7 * VS_] = (bf16_t)(rv.w >> 16); }
        GLA_FLUSH();
        GLA_SYNC();
#ifndef DBG_GLA_SYNCLOAD
        if (c + 1 < 33) GLA_PREFETCH(c + 1);
#endif
        { typedef float f32x2_t __attribute__((ext_vector_type(2)));
          const int d2 = (tid & 63) * 2, part = w, t0 = part * 8;
          float c0[8], c1[8]; float r0 = 0.f, r1 = 0.f;
#pragma unroll
          for (int i = 0; i < 8; ++i) { const f32x2_t g = *(const LAS f32x2_t*)(GK + (t0 + i) * 128 + d2); r0 += g.x * 1.44269504f; r1 += g.y * 1.44269504f; c0[i] = r0; c1[i] = r1; }
          *(LAS f32x2_t*)(PT + part * 128 + d2) = (f32x2_t){r0, r1};
          GLA_SYNC();
          float o0 = 0.f, o1 = 0.f, bl0 = 0.f, bl1 = 0.f;
#pragma unroll
          for (int p = 0; p < 8; ++p) { const f32x2_t v = *(const LAS f32x2_t*)(PT + p * 128 + d2); if (p < part) { o0 += v.x; o1 += v.y; } bl0 += v.x; bl1 += v.y; }
          const float E0 = __builtin_amdgcn_exp2f(bl0), E1 = __builtin_amdgcn_exp2f(bl1);
          unsigned kh0[4], kh1[4];
#pragma unroll
          for (int i = 0; i < 8; i += 2) {
              LAS unsigned* qp0 = (LAS unsigned*)(QT + (t0 + i) * QS + d2); LAS unsigned* qp1 = (LAS unsigned*)(QT + (t0 + i + 1) * QS + d2);
              LAS unsigned* kp0 = (LAS unsigned*)(KT + (t0 + i) * QS + d2); LAS unsigned* kp1 = (LAS unsigned*)(KT + (t0 + i + 1) * QS + d2);
              const unsigned qa = *qp0, qb = *qp1, ka = *kp0, kb = *kp1;
              const float b00 = o0 + c0[i], b01 = o1 + c1[i], b10 = o0 + c0[i + 1], b11 = o1 + c1[i + 1];
              const float n00 = bflo(ka) * __builtin_amdgcn_exp2f(-b00), n01 = bfhi(ka) * __builtin_amdgcn_exp2f(-b01), n10 = bflo(kb) * __builtin_amdgcn_exp2f(-b10), n11 = bfhi(kb) * __builtin_amdgcn_exp2f(-b11);
              *qp0 = pk_bf16(bflo(qa) * __builtin_amdgcn_exp2f(b00), bfhi(qa) * __builtin_amdgcn_exp2f(b01)); *qp1 = pk_bf16(bflo(qb) * __builtin_amdgcn_exp2f(b10), bfhi(qb) * __builtin_amdgcn_exp2f(b11));
              *kp0 = pk_bf16(n00, n01); *kp1 = pk_bf16(n10, n11);
              kh0[i >> 1] = pk_bf16(n00 * E0, n10 * E0); kh1[i >> 1] = pk_bf16(n01 * E1, n11 * E1); }
          *(LAS u32x4*)(KH + d2 * VS_ + t0) = (u32x4){kh0[0], kh0[1], kh0[2], kh0[3]}; *(LAS u32x4*)(KH + (d2 + 1) * VS_ + t0) = (u32x4){kh1[0], kh1[1], kh1[2], kh1[3]};
          if (part == 0) { DC[d2] = E0; DC[d2 + 1] = E1; } }
        GLA_SYNC();
        { const int ti = w >> 1;
#pragma unroll
          for (int jj = 0; jj < 2; ++jj) { const int sj = (w & 1) * 2 + jj; f32x4 acc = {0.f, 0.f, 0.f, 0.f};
              if (sj <= ti) {
#pragma unroll
                  for (int kk = 0; kk < 4; ++kk) { const bf16x8 ao = *(const LAS bf16x8*)(KT + (16 * sj + fr) * QS + 32 * kk + 8 * fq), bo = *(const LAS bf16x8*)(QT + (16 * ti + fr) * QS + 32 * kk + 8 * fq);
                      acc = __builtin_amdgcn_mfma_f32_16x16x32_bf16(ao, bo, acc, 0, 0, 0); }
                  if (sj == ti) {
#pragma unroll
                      for (int e = 0; e < 4; ++e) if (4 * fq + e > fr) acc[e] = 0.f; }
              }
              u32x2 wv; wv.x = pk_bf16(acc[0], acc[1]); wv.y = pk_bf16(acc[2], acc[3]);
              *(LAS u32x2*)(AM + (16 * ti + fr) * VS_ + 16 * sj + 4 * fq) = wv; } }
        GLA_SYNC();
        { const int ti = w >> 1; const int t = 16 * ti + fr; const int nv = c == 0 ? 16 : 64; float sq = 0.f;
          const int row = GLA_ROW(c, t);
#pragma unroll
          for (int jj = 0; jj < 2; ++jj) { const int jv = (w & 1) * 2 + jj; f32x4 acc = {0.f, 0.f, 0.f, 0.f};
#pragma unroll
              for (int kk = 0; kk < 2; ++kk) { const bf16x8 ao = *(const LAS bf16x8*)(VT + (16 * jv + fr) * VS_ + 32 * kk + 8 * fq), bo = *(const LAS bf16x8*)(AM + (16 * ti + fr) * VS_ + 32 * kk + 8 * fq);
                  acc = __builtin_amdgcn_mfma_f32_16x16x32_bf16(ao, bo, acc, 0, 0, 0); }
#pragma unroll
              for (int kk = 0; kk < 4; ++kk) { const bf16x8 ao = *(const LAS bf16x8*)(ST + (16 * jv + fr) * QS + 32 * kk + 8 * fq), bo = *(const LAS bf16x8*)(QT + (16 * ti + fr) * QS + 32 * kk + 8 * fq);
                  acc = __builtin_amdgcn_mfma_f32_16x16x32_bf16(ao, bo, acc, 0, 0, 0); }
              sq += (acc[0] * acc[0] + acc[1] * acc[1]) + (acc[2] * acc[2] + acc[3] * acc[3]);
              { u32x2 wv; wv.x = pk_bf16(acc[0], acc[1]); wv.y = pk_bf16(acc[2], acc[3]); if (jj == 0) ow0 = wv; else ow1 = wv; } }
          osq = sq; orow = t < nv ? row : -1; }
        { const int jv = w >> 1;
#pragma unroll
          for (int x = 0; x < 4; ++x) { const int jd = (w & 1) * 4 + x; const float dcy = DC[16 * jd + fr]; sacc[x] = sacc[x] * dcy;
#pragma unroll
              for (int kk = 0; kk < 2; ++kk) { const bf16x8 ao = *(const LAS bf16x8*)(VT + (16 * jv + fr) * VS_ + 32 * kk + 8 * fq), bo = *(const LAS bf16x8*)(KH + (16 * jd + fr) * VS_ + 32 * kk + 8 * fq);
                  sacc[x] = __builtin_amdgcn_mfma_f32_16x16x32_bf16(ao, bo, sacc[x], 0, 0, 0); } } }
        GLA_SYNC();
        { const int jv = w >> 1;
#pragma unroll
          for (int x = 0; x < 4; ++x) { const int jd = (w & 1) * 4 + x;
#pragma unroll
              for (int e = 0; e < 4; ++e) ST[(16 * jv + 4 * fq + e) * QS + 16 * jd + fr] = f2bf(sacc[x][e]); } }
    }
    GLA_FLUSH();
    { const int jv = w >> 1;
#pragma unroll
      for (int x = 0; x < 4; ++x) { const int d = 16 * ((w & 1) * 4 + x) + fr; *(f32x4*)(pgla + ((size_t)((b * 4 + h) * 128 + d)) * 256 + vs * 64 + 16 * jv + 4 * fq) = sacc[x]; } }
#undef GLA_ROW
#undef GLA_FLUSH
#undef GLA_PREFETCH
}

__device__ __forceinline__ void unpack8(const u32x4 w, float (&f)[8]) { f[0] = bflo(w.x); f[1] = bfhi(w.x); f[2] = bflo(w.y); f[3] = bfhi(w.y); f[4] = bflo(w.z); f[5] = bfhi(w.z); f[6] = bflo(w.w); f[7] = bfhi(w.w); }
__device__ __forceinline__ void gla_sample_item(LAS unsigned char* lds, int item, int layer, const bf16_t* proj, const float* gkb, const float* sgla_in, float* sgla_out, const float* gain, bf16_t* b_in) {
    const int tid = ltid(), lane = tid & 63, w = tid >> 6, s = item >> 2, h = item & 3, row = NPROMPT + s, c4 = lane * 4;
    LAS float* red = (LAS float*)lds;
    LAS float* wsum = red + 8 * 256;
    const bf16_t* pr = proj + (size_t)row * NPROJ;
    const u32x2 vw = *(const u32x2*)(pr + C_V + h * 256 + c4);
    const f32x4 v4 = {bflo(vw.x), bfhi(vw.x), bflo(vw.y), bfhi(vw.y)};
    const size_t sbase = ((size_t)((layer * 128 + s) * 4 + h) * 128) * 256;
    f32x4 oacc = {0.f, 0.f, 0.f, 0.f};
    __syncthreads();
    { f32x4 sv[16]; float qd[16], kd[16], eg[16];
#pragma unroll
      for (int i = 0; i < 16; ++i) { const int dk = w * 16 + i; sv[i] = __builtin_nontemporal_load((const f32x4*)(sgla_in + sbase + (size_t)dk * 256 + c4)); }
      const u32x4 q0 = *(const u32x4*)(pr + C_Q + h * 128 + w * 16), q1 = *(const u32x4*)(pr + C_Q + h * 128 + w * 16 + 8);
      const u32x4 k0 = *(const u32x4*)(pr + C_K + h * 128 + w * 16), k1 = *(const u32x4*)(pr + C_K + h * 128 + w * 16 + 8);
      { float t8[8]; unpack8(q0, t8);
#pragma unroll
        for (int e = 0; e < 8; ++e) qd[e] = t8[e];
        unpack8(q1, t8);
#pragma unroll
        for (int e = 0; e < 8; ++e) qd[8 + e] = t8[e];
        unpack8(k0, t8);
#pragma unroll
        for (int e = 0; e < 8; ++e) kd[e] = t8[e];
        unpack8(k1, t8);
#pragma unroll
        for (int e = 0; e < 8; ++e) kd[8 + e] = t8[e]; }
#pragma unroll
      for (int j = 0; j < 4; ++j) { const f32x4 g4 = *(const f32x4*)(gkb + (size_t)row * 512 + h * 128 + w * 16 + 4 * j); eg[4 * j] = g4[0]; eg[4 * j + 1] = g4[1]; eg[4 * j + 2] = g4[2]; eg[4 * j + 3] = g4[3]; }
#pragma unroll
      for (int i = 0; i < 16; ++i) { const int dk = w * 16 + i; const f32x4 sn = sv[i] * __expf(eg[i]) + v4 * kd[i];
          __builtin_nontemporal_store(sn, (f32x4*)(sgla_out + sbase + (size_t)dk * 256 + c4)); oacc += sn * qd[i]; } }
    *(LAS f32x4*)(red + w * 256 + c4) = oacc;
    __syncthreads();
    float o = 0.f;
    if (tid < 256) {
#pragma unroll
        for (int g = 0; g < 8; ++g) o += red[g * 256 + tid];
        const float sq = wave_sum(o * o); if (lane == 0) wsum[w] = sq; }
    __syncthreads();
    if (tid < 256) { const float tot = (wsum[0] + wsum[1]) + (wsum[2] + wsum[3]); const float rs = rsqrtf(tot * (1.f / 256.f) + EPS);
        const float og = bf2f(pr[C_OG + h * 256 + tid]);
        b_in[(size_t)row * DM + h * 256 + tid] = f2bf(o * rs * gain[tid] * silu(og)); }
}

__device__ __forceinline__ void conv_rows(int it, int layer, const bf16_t* proj, const float* conv_w, const float* state_conv, bf16_t* a_in, float* pconv, float* sconv) {
    const int tid = ltid(), row = it * 4 + (tid >> 7), c8 = (tid & 127) * 8;
    float u0[8], u1[8], u2[8], gB[8], cw0[8], cw1[8], cw2[8], a[8], b_[8];
    const bf16_t* pr = proj + (size_t)row * NPROJ + c8;
    unpack8(*(const u32x4*)(pr + C_GC), a); unpack8(*(const u32x4*)(pr + C_H), b_);
#pragma unroll
    for (int e = 0; e < 8; ++e) u0[e] = a[e] * b_[e];
    unpack8(*(const u32x4*)(pr + C_GB), gB);
    int r1 = -1, r2 = -1;
    if (row < NREAL) { const int bb = row >> 11, t = row & 2047; r1 = t >= 1 ? row - 1 : NREAL + bb * 16 + 15; r2 = t >= 2 ? row - 2 : NREAL + bb * 16 + 14 + t; }
    else if (row < NPROMPT) { const int i = (row - NREAL) & 15; r1 = i >= 1 ? row - 1 : -1; r2 = i >= 2 ? row - 2 : -1; }
    if (row >= NPROMPT) { const int s = row - NPROMPT; const float* st = state_conv + ((size_t)(layer * 128 + s) * 2) * 1024 + c8;
#pragma unroll
        for (int e = 0; e < 8; ++e) { u2[e] = st[e]; u1[e] = st[1024 + e]; }
        float* so = sconv + ((size_t)(layer * 128 + s) * 2) * 1024 + c8;
        *(f32x4*)so = (f32x4){u1[0], u1[1], u1[2], u1[3]}; *(f32x4*)(so + 4) = (f32x4){u1[4], u1[5], u1[6], u1[7]};
        *(f32x4*)(so + 1024) = (f32x4){u0[0], u0[1], u0[2], u0[3]}; *(f32x4*)(so + 1028) = (f32x4){u0[4], u0[5], u0[6], u0[7]};
    } else {
        if (r1 >= 0) { const bf16_t* p1 = proj + (size_t)r1 * NPROJ + c8; unpack8(*(const u32x4*)(p1 + C_GC), a); unpack8(*(const u32x4*)(p1 + C_H), b_);
#pragma unroll
            for (int e = 0; e < 8; ++e) u1[e] = a[e] * b_[e]; }
        else {
#pragma unroll
            for (int e = 0; e < 8; ++e) u1[e] = 0.f; }
        if (r2 >= 0) { const bf16_t* p2 = proj + (size_t)r2 * NPROJ + c8; unpack8(*(const u32x4*)(p2 + C_GC), a); unpack8(*(const u32x4*)(p2 + C_H), b_);
#pragma unroll
            for (int e = 0; e < 8; ++e) u2[e] = a[e] * b_[e]; }
        else {
#pragma unroll
            for (int e = 0; e < 8; ++e) u2[e] = 0.f; }
        if (row < NREAL && (row & 2047) >= 2046) { float* po = pconv + ((size_t)((layer * 8 + (row >> 11)) * 2 + ((row & 2047) - 2046))) * 1024 + c8;
            *(f32x4*)po = (f32x4){u0[0], u0[1], u0[2], u0[3]}; *(f32x4*)(po + 4) = (f32x4){u0[4], u0[5], u0[6], u0[7]}; }
    }
    const float* cw = conv_w + (size_t)layer * 3 * 1024 + c8;
#pragma unroll
    for (int e = 0; e < 8; ++e) { cw0[e] = cw[e]; cw1[e] = cw[1024 + e]; cw2[e] = cw[2048 + e]; }
    float y[8];
#pragma unroll
    for (int e = 0; e < 8; ++e) y[e] = gB[e] * (cw0[e] * u2[e] + cw1[e] * u1[e] + cw2[e] * u0[e]);
    u32x4 wv; wv.x = pk_bf16(y[0], y[1]); wv.y = pk_bf16(y[2], y[3]); wv.z = pk_bf16(y[4], y[5]); wv.w = pk_bf16(y[6], y[7]);
    *(u32x4*)(a_in + (size_t)row * DM + c8) = wv;
}

__device__ __forceinline__ void conv_prompt2(int it0, int stride, int it_end, int layer, const bf16_t* proj, const float* conv_w, bf16_t* a_in, float* pconv) {
    const int tid = ltid(), c8 = (tid & 127) * 8; u32x4 gc[2][3], hh[2][3], gb[2]; int rows[2]; bool v1[2], v2[2];
#pragma unroll
    for (int u = 0; u < 2; ++u) { const int it = it0 + u * stride; rows[u] = it < it_end ? it * 4 + (tid >> 7) : -1; v1[u] = false; v2[u] = false;
        if (rows[u] >= 0) { const int row = rows[u]; int r1, r2;
            if (row < NREAL) { const int bb = row >> 11, t = row & 2047; r1 = t >= 1 ? row - 1 : NREAL + bb * 16 + 15; r2 = t >= 2 ? row - 2 : NREAL + bb * 16 + 14 + t; }
            else { const int i = (row - NREAL) & 15; r1 = i >= 1 ? row - 1 : -1; r2 = i >= 2 ? row - 2 : -1; }
            v1[u] = r1 >= 0; v2[u] = r2 >= 0; if (r1 < 0) r1 = row; if (r2 < 0) r2 = row;
            const bf16_t* p0 = proj + (size_t)row * NPROJ + c8; const bf16_t* p1 = proj + (size_t)r1 * NPROJ + c8; const bf16_t* p2 = proj + (size_t)r2 * NPROJ + c8;
            gc[u][0] = __builtin_nontemporal_load((const u32x4*)(p0 + C_GC)); hh[u][0] = __builtin_nontemporal_load((const u32x4*)(p0 + C_H)); gb[u] = __builtin_nontemporal_load((const u32x4*)(p0 + C_GB));
            gc[u][1] = __builtin_nontemporal_load((const u32x4*)(p1 + C_GC)); hh[u][1] = __builtin_nontemporal_load((const u32x4*)(p1 + C_H)); gc[u][2] = __builtin_nontemporal_load((const u32x4*)(p2 + C_GC)); hh[u][2] = __builtin_nontemporal_load((const u32x4*)(p2 + C_H)); } }
    const float* cw = conv_w + (size_t)layer * 3 * 1024 + c8; float cw0[8], cw1[8], cw2[8];
#pragma unroll
    for (int e = 0; e < 8; ++e) { cw0[e] = cw[e]; cw1[e] = cw[1024 + e]; cw2[e] = cw[2048 + e]; }
#pragma unroll
    for (int u = 0; u < 2; ++u) if (rows[u] >= 0) { const int row = rows[u]; float a[8], b_[8], u0[8], u1[8], u2[8], gB[8], y[8];
        unpack8(gc[u][0], a); unpack8(hh[u][0], b_);
#pragma unroll
        for (int e = 0; e < 8; ++e) u0[e] = a[e] * b_[e];
        unpack8(gc[u][1], a); unpack8(hh[u][1], b_);
#pragma unroll
        for (int e = 0; e < 8; ++e) u1[e] = v1[u] ? a[e] * b_[e] : 0.f;
        unpack8(gc[u][2], a); unpack8(hh[u][2], b_);
#pragma unroll
        for (int e = 0; e < 8; ++e) u2[e] = v2[u] ? a[e] * b_[e] : 0.f;
        unpack8(gb[u], gB);
        if (row < NREAL && (row & 2047) >= 2046) { float* po = pconv + ((size_t)((layer * 8 + (row >> 11)) * 2 + ((row & 2047) - 2046))) * 1024 + c8;
            *(f32x4*)po = (f32x4){u0[0], u0[1], u0[2], u0[3]}; *(f32x4*)(po + 4) = (f32x4){u0[4], u0[5], u0[6], u0[7]}; }
#pragma unroll
        for (int e = 0; e < 8; ++e) y[e] = gB[e] * (cw0[e] * u2[e] + cw1[e] * u1[e] + cw2[e] * u0[e]);
        u32x4 wv; wv.x = pk_bf16(y[0], y[1]); wv.y = pk_bf16(y[2], y[3]); wv.z = pk_bf16(y[4], y[5]); wv.w = pk_bf16(y[6], y[7]);
        *(u32x4*)(a_in + (size_t)row * DM + c8) = wv; }
}

__device__ __forceinline__ void prep_rows4(int it0, int stride, const bf16_t* proj, const bf16_t* obuf, const float* ossq, const float* gain, bf16_t* b_in) {
    const int tid = ltid(), c8 = (tid & 127) * 8; u32x4 ov[4], gv[4]; float sv[4]; int rows[4];
#pragma unroll
    for (int u = 0; u < 4; ++u) { const int it = it0 + u * stride; rows[u] = it < NPROMPT / 4 ? it * 4 + (tid >> 7) : -1;
        if (rows[u] >= 0) { ov[u] = __builtin_nontemporal_load((const u32x4*)(obuf + (size_t)rows[u] * DM + c8)); gv[u] = __builtin_nontemporal_load((const u32x4*)(proj + (size_t)rows[u] * NPROJ + C_OG + c8)); sv[u] = ossq[(size_t)rows[u] * 4 + (c8 >> 8)]; } }
    const float* gn = gain + (c8 & 255); const f32x4 g0 = *(const f32x4*)gn, g1 = *(const f32x4*)(gn + 4);
#pragma unroll
    for (int u = 0; u < 4; ++u) if (rows[u] >= 0) { float o[8], g[8]; unpack8(ov[u], o); unpack8(gv[u], g); const float rs = rsqrtf(sv[u] * (1.f / 256.f) + EPS);
        float y[8];
#pragma unroll
        for (int e = 0; e < 8; ++e) y[e] = o[e] * rs * (e < 4 ? g0[e & 3] : g1[e & 3]) * silu(g[e]);
        u32x4 wv; wv.x = pk_bf16(y[0], y[1]); wv.y = pk_bf16(y[2], y[3]); wv.z = pk_bf16(y[4], y[5]); wv.w = pk_bf16(y[6], y[7]);
        *(u32x4*)(b_in + (size_t)rows[u] * DM + c8) = wv; }
}

template <bool ADD> struct TailGate {
    const bf16_t* gate; bf16_t* mb;
    __device__ __forceinline__ void operator()(const f32x4 a, int row, int col, int fq) const {
        const u32x2 g = *(const u32x2*)(gate + (size_t)row * NPROJ + col); bf16_t* op = mb + (size_t)row * DM + col;
        float r0 = sigm(bflo(g.x)) * a[0], r1 = sigm(bfhi(g.x)) * a[1], r2 = sigm(bflo(g.y)) * a[2], r3 = sigm(bfhi(g.y)) * a[3];
        if (ADD) { const u32x2 o = *(const u32x2*)op; r0 += bflo(o.x); r1 += bfhi(o.x); r2 += bflo(o.y); r3 += bfhi(o.y); }
        u32x2 w; w.x = pk_bf16(r0, r1); w.y = pk_bf16(r2, r3); *(u32x2*)op = w;
    }
};
struct TailResid {
    bf16_t* xb; float* ssn;
    __device__ __forceinline__ void operator()(const f32x4 a, int row, int col, int fq) const {
        bf16_t* bp = xb + (size_t)row * DM + col; const u32x2 o = *(const u32x2*)bp;
        u32x2 w; w.x = pk_bf16(bflo(o.x) + a[0], bfhi(o.x) + a[1]); w.y = pk_bf16(bflo(o.y) + a[2], bfhi(o.y) + a[3]); *(u32x2*)bp = w;
        const float r0 = bflo(w.x), r1 = bfhi(w.x), r2 = bflo(w.y), r3 = bfhi(w.y);
        float s = (r0 * r0 + r1 * r1) + (r2 * r2 + r3 * r3); s += __shfl_xor(s, 16); s += __shfl_xor(s, 32);
        if (fq == 0) atomicAdd(ssn + row, s);
    }
};
template <class TE> __device__ __forceinline__ void tail_gemm(LAS unsigned char* lds, const bf16_t* A, const bf16_t* Bt, int K, const TE& E) {
    const int tid = ltid(), lane = tid & 63, w = __builtin_amdgcn_readfirstlane(tid >> 6), fr = lane & 15, fq = lane >> 4, G = gridDim.x, wp = w & 3, half = w >> 2, Kh = K >> 1;
    LAS f32x4* xch = (LAS f32x4*)lds;
    const int ntrip = (1024 + 4 * G - 1) / (4 * G);
    for (int trip = 0; trip < ntrip; ++trip) {
        const int tile = wp * G + (int)blockIdx.x + trip * 4 * G; const bool ok = tile < 1024;
        const int tm = tile >> 6, tn = tile & 63;
        f32x4 acc = {0.f, 0.f, 0.f, 0.f};
        if (ok) { const bf16_t* ap = A + (size_t)(NREAL + tm * 16 + fr) * K + half * Kh + 8 * fq; const bf16_t* bp = Bt + (size_t)(tn * 16 + fr) * K + half * Kh + 8 * fq;
#pragma unroll 16
            for (int k0 = 0; k0 < Kh; k0 += 32) { const bf16x8 a = *(const bf16x8*)(ap + k0), b = *(const bf16x8*)(bp + k0); acc = __builtin_amdgcn_mfma_f32_16x16x32_bf16(b, a, acc, 0, 0, 0); } }
        __syncthreads();
        if (half == 1) xch[wp * 64 + lane] = acc;
        __syncthreads();
        if (half == 0 && ok) { acc += xch[wp * 64 + lane]; E(acc, NREAL + tm * 16 + fr, tn * 16 + 4 * fq, fq); }
    }
    __syncthreads();
}
__device__ __forceinline__ unsigned char* gla_seg(unsigned char* gkbytes, unsigned char* g0, int b, int h, int c, int t) {
    return c == 0 ? g0 + ((size_t)((b * 4 + h) * 64 + t)) * 512 : gkbytes + ((size_t)(b * 2048 + (c - 1) * 64 + t) * 512 + h * 128) * 4;
}
struct GlaPre { u32x4 rq[2], rk[2], rg[4]; };
__device__ __forceinline__ void gla_pre_load(GlaPre& R, int item, const bf16_t* proj, const float* gkb) {
    const int tid = ltid(), c = item % 33, bh = item / 33, b = bh >> 2, h = bh & 3, nv = c == 0 ? 16 : 64;
    const int qt0 = tid >> 4, qc = tid & 15, gt0 = tid >> 5, gc = tid & 31; const u32x4 z4 = {0u, 0u, 0u, 0u};
#pragma unroll
    for (int i = 0; i < 2; ++i) { const int t = qt0 + 32 * i; const int row = c == 0 ? NREAL + b * 16 + t : b * 2048 + (c - 1) * 64 + t; const bf16_t* p = proj + (size_t)row * NPROJ + h * 128 + qc * 8;
        R.rq[i] = t < nv ? __builtin_nontemporal_load((const u32x4*)(p + C_Q)) : z4; R.rk[i] = t < nv ? __builtin_nontemporal_load((const u32x4*)(p + C_K)) : z4; }
#pragma unroll
    for (int i = 0; i < 4; ++i) { const int t = gt0 + 16 * i; const int row = c == 0 ? NREAL + b * 16 + t : b * 2048 + (c - 1) * 64 + t; R.rg[i] = t < nv ? __builtin_nontemporal_load((const u32x4*)(gkb + (size_t)row * 512 + h * 128 + gc * 4)) : z4; }
}
__device__ __forceinline__ void gla_pre_item(LAS unsigned char* lds, int item, bf16_t* proj, float* gkb, unsigned char* g0, const GlaPre& R) {
    const int tid = ltid(), lane = tid & 63, w = __builtin_amdgcn_readfirstlane(tid >> 6), fr = lane & 15, fq = lane >> 4;
    const int c = item % 33, bh = item / 33, b = bh >> 2, h = bh & 3, nv = c == 0 ? 16 : 64;
    LAS bf16_t* QT = (LAS bf16_t*)lds; LAS bf16_t* KT = (LAS bf16_t*)(lds + 17408); LAS float* GK = (LAS float*)(lds + 34816); LAS bf16_t* KH = (LAS bf16_t*)(lds + 67584);
    LAS bf16_t* AM = (LAS bf16_t*)(lds + 95232); LAS float* PT = (LAS float*)(lds + 121856); LAS float* DC = (LAS float*)(lds + 125952);
    const int qt0 = tid >> 4, qc = tid & 15, gt0 = tid >> 5, gc = tid & 31;
#define GLA_ROW(c, t) ((c) == 0 ? NREAL + b * 16 + (t) : b * 2048 + ((c) - 1) * 64 + (t))
    GLA_SYNC();
    {
#pragma unroll
      for (int i = 0; i < 2; ++i) { const int t = qt0 + 32 * i; *(LAS u32x4*)(QT + t * QS + qc * 8) = R.rq[i]; *(LAS u32x4*)(KT + t * QS + qc * 8) = R.rk[i]; }
#pragma unroll
      for (int i = 0; i < 4; ++i) { const int t = gt0 + 16 * i; *(LAS u32x4*)(GK + t * 128 + gc * 4) = R.rg[i]; } }
    GLA_SYNC();
        { typedef float f32x2_t __attribute__((ext_vector_type(2)));
          const int d2 = (tid & 63) * 2, part = w, t0 = part * 8;
          float c0[8], c1[8]; float r0 = 0.f, r1 = 0.f;
#pragma unroll
          for (int i = 0; i < 8; ++i) { const f32x2_t g = *(const LAS f32x2_t*)(GK + (t0 + i) * 128 + d2); r0 += g.x * 1.44269504f; r1 += g.y * 1.44269504f; c0[i] = r0; c1[i] = r1; }
          *(LAS f32x2_t*)(PT + part * 128 + d2) = (f32x2_t){r0, r1};
          GLA_SYNC();
          float o0 = 0.f, o1 = 0.f, bl0 = 0.f, bl1 = 0.f;
#pragma unroll
          for (int p = 0; p < 8; ++p) { const f32x2_t v = *(const LAS f32x2_t*)(PT + p * 128 + d2); if (p < part) { o0 += v.x; o1 += v.y; } bl0 += v.x; bl1 += v.y; }
          const float E0 = __builtin_amdgcn_exp2f(bl0), E1 = __builtin_amdgcn_exp2f(bl1);
          unsigned kh0[4], kh1[4];
#pragma unroll
          for (int i = 0; i < 8; i += 2) {
              LAS unsigned* qp0 = (LAS unsigned*)(QT + (t0 + i) * QS + d2); LAS unsigned* qp1 = (LAS unsigned*)(QT + (t0 + i + 1) * QS + d2);
              LAS unsigned* kp0 = (LAS unsigned*)(KT + (t0 + i) * QS + d2); LAS unsigned* kp1 = (LAS unsigned*)(KT + (t0 + i + 1) * QS + d2);
              const unsigned qa = *qp0, qb = *qp1, ka = *kp0, kb = *kp1;
              const float b00 = o0 + c0[i], b01 = o1 + c1[i], b10 = o0 + c0[i + 1], b11 = o1 + c1[i + 1];
              const float n00 = bflo(ka) * __builtin_amdgcn_exp2f(-b00), n01 = bfhi(ka) * __builtin_amdgcn_exp2f(-b01), n10 = bflo(kb) * __builtin_amdgcn_exp2f(-b10), n11 = bfhi(kb) * __builtin_amdgcn_exp2f(-b11);
              *qp0 = pk_bf16(bflo(qa) * __builtin_amdgcn_exp2f(b00), bfhi(qa) * __builtin_amdgcn_exp2f(b01)); *qp1 = pk_bf16(bflo(qb) * __builtin_amdgcn_exp2f(b10), bfhi(qb) * __builtin_amdgcn_exp2f(b11));
              *kp0 = pk_bf16(n00, n01); *kp1 = pk_bf16(n10, n11);
              kh0[i >> 1] = pk_bf16(n00 * E0, n10 * E0); kh1[i >> 1] = pk_bf16(n01 * E1, n11 * E1); }
          *(LAS u32x4*)(KH + d2 * VS_ + t0) = (u32x4){kh0[0], kh0[1], kh0[2], kh0[3]}; *(LAS u32x4*)(KH + (d2 + 1) * VS_ + t0) = (u32x4){kh1[0], kh1[1], kh1[2], kh1[3]};
          if (part == 0) { DC[d2] = E0; DC[d2 + 1] = E1; } }
        GLA_SYNC();
        { const int ti = w >> 1;
#pragma unroll
          for (int jj = 0; jj < 2; ++jj) { const int sj = (w & 1) * 2 + jj; f32x4 acc = {0.f, 0.f, 0.f, 0.f};
              if (sj <= ti) {
#pragma unroll
                  for (int kk = 0; kk < 4; ++kk) { const bf16x8 ao = *(const LAS bf16x8*)(KT + (16 * sj + fr) * QS + 32 * kk + 8 * fq), bo = *(const LAS bf16x8*)(QT + (16 * ti + fr) * QS + 32 * kk + 8 * fq);
                      acc = __builtin_amdgcn_mfma_f32_16x16x32_bf16(ao, bo, acc, 0, 0, 0); }
                  if (sj == ti) {
#pragma unroll
                      for (int e = 0; e < 4; ++e) if (4 * fq + e > fr) acc[e] = 0.f; }
              }
              u32x2 wv; wv.x = pk_bf16(acc[0], acc[1]); wv.y = pk_bf16(acc[2], acc[3]);
              *(LAS u32x2*)(AM + (16 * ti + fr) * VS_ + 16 * sj + 4 * fq) = wv; } }
        GLA_SYNC();
    unsigned char* gkbytes = (unsigned char*)gkb;
#pragma unroll
    for (int i = 0; i < 2; ++i) { const int t = qt0 + 32 * i; if (t < nv) *(u32x4*)(proj + (size_t)GLA_ROW(c, t) * NPROJ + C_Q + h * 128 + qc * 8) = *(const LAS u32x4*)(QT + t * QS + qc * 8); }
#pragma unroll
    for (int j = 0; j < 2; ++j) { const int i = tid + 512 * j, d = i >> 3, pc = i & 7; *(u32x4*)(gla_seg(gkbytes, g0, b, h, c, d >> 1) + (d & 1) * 128 + pc * 16) = *(const LAS u32x4*)(KH + d * VS_ + pc * 8); }
    { const int t = tid >> 3, pc = tid & 7; *(u32x4*)(gla_seg(gkbytes, g0, b, h, c, t) + 256 + pc * 16) = *(const LAS u32x4*)(AM + t * VS_ + pc * 8); }
    if (tid < 64) { typedef float f32x2_t __attribute__((ext_vector_type(2))); *(f32x2_t*)(gla_seg(gkbytes, g0, b, h, c, tid) + 384) = *(const LAS f32x2_t*)(DC + 2 * tid); }
#undef GLA_ROW
}

struct GlaSet { u32x4 rq[2], rkh[2], ram, rv; u32x2 rdc; };
struct GlaSeqCtx { const bf16_t* proj; unsigned char* gkbytes; unsigned char* g0; bf16_t* obuf; float* ossq; int b, h, vs, tid, w, fr, fq; bool do_atomic; };
#define GLA_ROW(c, t) ((c) == 0 ? NREAL + X.b * 16 + (t) : X.b * 2048 + ((c) - 1) * 64 + (t))
__device__ __forceinline__ void gla_seq_prefetch(GlaSet& R, const GlaSeqCtx& X, int c) {
    const int tid = X.tid, qt0 = tid >> 4, qc = tid & 15, vt = tid >> 3, vc = tid & 7, nv = c == 0 ? 16 : 64; const u32x4 z4 = {0u, 0u, 0u, 0u};
#pragma unroll
    for (int i = 0; i < 2; ++i) { const int t = qt0 + 32 * i; R.rq[i] = t < nv ? *(const u32x4*)(X.proj + (size_t)GLA_ROW(c, t) * NPROJ + C_Q + X.h * 128 + qc * 8) : z4; }
#pragma unroll
    for (int j = 0; j < 2; ++j) { const int i = tid + 512 * j, d = i >> 3, pc = i & 7; R.rkh[j] = *(const u32x4*)(gla_seg(X.gkbytes, X.g0, X.b, X.h, c, d >> 1) + (d & 1) * 128 + pc * 16); }
    R.ram = *(const u32x4*)(gla_seg(X.gkbytes, X.g0, X.b, X.h, c, vt) + 256 + vc * 16);
    R.rv = vt < nv ? __builtin_nontemporal_load((const u32x4*)(X.proj + (size_t)GLA_ROW(c, vt) * NPROJ + C_V + X.h * 256 + X.vs * 64 + vc * 8)) : z4;
    R.rdc = (u32x2){0u, 0u}; if (tid < 64) R.rdc = *(const u32x2*)(gla_seg(X.gkbytes, X.g0, X.b, X.h, c, tid) + 384);
}
__device__ __forceinline__ void gla_seq_chunk(LAS unsigned char* lds, GlaSet& R, const GlaSeqCtx& X, int c, f32x4 (&sacc)[4], u32x2& ow0, u32x2& ow1, float& osq, int& orow) {
    const int tid = X.tid, w = X.w, fr = X.fr, fq = X.fq, h = X.h, vs = X.vs, qt0 = tid >> 4, qc = tid & 15, vt = tid >> 3, vc = tid & 7;
    LAS bf16_t* QT = (LAS bf16_t*)lds; LAS bf16_t* KH = (LAS bf16_t*)(lds + 17408); LAS bf16_t* VT = (LAS bf16_t*)(lds + 35840); LAS bf16_t* AM = (LAS bf16_t*)(lds + 45056);
    LAS bf16_t* ST = (LAS bf16_t*)(lds + 54272); LAS float* DC = (LAS float*)(lds + 71680);
#pragma unroll
    for (int i = 0; i < 2; ++i) { const int t = qt0 + 32 * i; *(LAS u32x4*)(QT + t * QS + qc * 8) = R.rq[i]; }
#pragma unroll
    for (int j = 0; j < 2; ++j) { const int i = tid + 512 * j, d = i >> 3, pc = i & 7; *(LAS u32x4*)(KH + d * VS_ + pc * 8) = R.rkh[j]; }
    *(LAS u32x4*)(AM + vt * VS_ + vc * 8) = R.ram;
    { const u32x4 rv = R.rv; LAS bf16_t* vp = VT + (vc * 8) * VS_ + vt;
      vp[0 * VS_] = (bf16_t)(rv.x & 0xffffu); vp[1 * VS_] = (bf16_t)(rv.x >> 16); vp[2 * VS_] = (bf16_t)(rv.y & 0xffffu); vp[3 * VS_] = (bf16_t)(rv.y >> 16);
      vp[4 * VS_] = (bf16_t)(rv.z & 0xffffu); vp[5 * VS_] = (bf16_t)(rv.z >> 16); vp[6 * VS_] = (bf16_t)(rv.w & 0xffffu); vp[7 * VS_] = (bf16_t)(rv.w >> 16); }
    if (tid < 64) *(LAS u32x2*)(DC + 2 * tid) = R.rdc;
    if (orow >= 0) { bf16_t* op_ = X.obuf + (size_t)orow * DM + h * 256 + vs * 64 + 32 * (w & 1) + 4 * fq; *(u32x2*)op_ = ow0; *(u32x2*)(op_ + 16) = ow1;
        float s_ = osq; s_ += __shfl_xor(s_, 16); s_ += __shfl_xor(s_, 32);
        if (fq == 0 && X.do_atomic) __hip_atomic_fetch_add((__attribute__((address_space(1))) float*)(X.ossq + (size_t)orow * 4 + h), s_, __ATOMIC_RELAXED, __HIP_MEMORY_SCOPE_AGENT); }
    GLA_SYNC();
    if (c + 2 < 33) gla_seq_prefetch(R, X, c + 2);
        { const int ti = w >> 1; const int t = 16 * ti + fr; const int nv = c == 0 ? 16 : 64; float sq = 0.f;
          const int row = GLA_ROW(c, t);
#pragma unroll
          for (int jj = 0; jj < 2; ++jj) { const int jv = (w & 1) * 2 + jj; f32x4 acc = {0.f, 0.f, 0.f, 0.f};
#pragma unroll
              for (int kk = 0; kk < 2; ++kk) { const bf16x8 ao = *(const LAS bf16x8*)(VT + (16 * jv + fr) * VS_ + 32 * kk + 8 * fq), bo = *(const LAS bf16x8*)(AM + (16 * ti + fr) * VS_ + 32 * kk + 8 * fq);
                  acc = __builtin_amdgcn_mfma_f32_16x16x32_bf16(ao, bo, acc, 0, 0, 0); }
#pragma unroll
              for (int kk = 0; kk < 4; ++kk) { const bf16x8 ao = *(const LAS bf16x8*)(ST + (16 * jv + fr) * QS + 32 * kk + 8 * fq), bo = *(const LAS bf16x8*)(QT + (16 * ti + fr) * QS + 32 * kk + 8 * fq);
                  acc = __builtin_amdgcn_mfma_f32_16x16x32_bf16(ao, bo, acc, 0, 0, 0); }
              sq += (acc[0] * acc[0] + acc[1] * acc[1]) + (acc[2] * acc[2] + acc[3] * acc[3]);
              { u32x2 wv; wv.x = pk_bf16(acc[0], acc[1]); wv.y = pk_bf16(acc[2], acc[3]); if (jj == 0) ow0 = wv; else ow1 = wv; } }
          osq = sq; orow = t < nv ? row : -1; }
        { const int jv = w >> 1;
#pragma unroll
          for (int x = 0; x < 4; ++x) { const int jd = (w & 1) * 4 + x; const float dcy = DC[16 * jd + fr]; sacc[x] = sacc[x] * dcy;
#pragma unroll
              for (int kk = 0; kk < 2; ++kk) { const bf16x8 ao = *(const LAS bf16x8*)(VT + (16 * jv + fr) * VS_ + 32 * kk + 8 * fq), bo = *(const LAS bf16x8*)(KH + (16 * jd + fr) * VS_ + 32 * kk + 8 * fq);
                  sacc[x] = __builtin_amdgcn_mfma_f32_16x16x32_bf16(ao, bo, sacc[x], 0, 0, 0); } } }
    GLA_SYNC();
        { const int jv = w >> 1;
#pragma unroll
          for (int x = 0; x < 4; ++x) { const int jd = (w & 1) * 4 + x;
#pragma unroll
              for (int e = 0; e < 4; ++e) ST[(16 * jv + 4 * fq + e) * QS + 16 * jd + fr] = f2bf(sacc[x][e]); } }
}
__device__ __forceinline__ void gla_seq_item(LAS unsigned char* lds, int item, const bf16_t* proj, unsigned char* gkbytes, unsigned char* g0, bf16_t* obuf, float* ossq, float* pgla, bool do_atomic = true) {
    GlaSeqCtx X; X.proj = proj; X.gkbytes = gkbytes; X.g0 = g0; X.obuf = obuf; X.ossq = ossq; X.do_atomic = do_atomic;
    X.tid = ltid(); const int lane = X.tid & 63; X.w = __builtin_amdgcn_readfirstlane(X.tid >> 6); X.fr = lane & 15; X.fq = lane >> 4;
    { const int xcd = item & 7, j = item >> 3, bh = xcd + 8 * (j >> 2); X.vs = j & 3; X.b = bh >> 2; X.h = bh & 3; }
    LAS bf16_t* ST = (LAS bf16_t*)(lds + 54272);
    GLA_SYNC();
    for (int i = X.tid; i < 64 * QS / 2; i += 512) ((LAS unsigned*)ST)[i] = 0u;
    f32x4 sacc[4];
#pragma unroll
    for (int x = 0; x < 4; ++x) sacc[x] = (f32x4){0.f, 0.f, 0.f, 0.f};
    u32x2 ow0 = {0u, 0u}, ow1 = {0u, 0u}; float osq = 0.f; int orow = -1;
    GlaSet R0, R1;
    gla_seq_prefetch(R0, X, 0); gla_seq_prefetch(R1, X, 1);
    for (int c = 0; c < 32; c += 2) { gla_seq_chunk(lds, R0, X, c, sacc, ow0, ow1, osq, orow); gla_seq_chunk(lds, R1, X, c + 1, sacc, ow0, ow1, osq, orow); }
    gla_seq_chunk(lds, R0, X, 32, sacc, ow0, ow1, osq, orow);
    { const int w = X.w, fr = X.fr, fq = X.fq, h = X.h, vs = X.vs;
      if (orow >= 0) { bf16_t* op_ = obuf + (size_t)orow * DM + h * 256 + vs * 64 + 32 * (w & 1) + 4 * fq; *(u32x2*)op_ = ow0; *(u32x2*)(op_ + 16) = ow1;
          float s_ = osq; s_ += __shfl_xor(s_, 16); s_ += __shfl_xor(s_, 32);
          if (fq == 0 && do_atomic) __hip_atomic_fetch_add((__attribute__((address_space(1))) float*)(ossq + (size_t)orow * 4 + h), s_, __ATOMIC_RELAXED, __HIP_MEMORY_SCOPE_AGENT); }
      const int jv = w >> 1;
#pragma unroll
      for (int x = 0; x < 4; ++x) { const int d = 16 * ((w & 1) * 4 + x) + fr; __builtin_nontemporal_store(sacc[x], (f32x4*)(pgla + ((size_t)((X.b * 4 + h) * 128 + d)) * 256 + vs * 64 + 16 * jv + 4 * fq)); } }
}
#undef GLA_ROW
#define XB_TMO      128
#define XB_XCNT(j)  (256  + 64 * (j))
#define XB_XSUB(j)  (1280 + 64 * (j))
#define XB_XGEN(j)  (2304 + 64 * (j))
#define XB_TOP      3328
#define XB_TOPGEN   3392
#define XCD_BAR_WORDS 3456
#define XB_SPIN_CAP (1u << 18)

__device__ __forceinline__ unsigned xb_ld(unsigned* p)              { return __hip_atomic_load(p, __ATOMIC_RELAXED, __HIP_MEMORY_SCOPE_AGENT); }
__device__ __forceinline__ unsigned xb_add(unsigned* p, unsigned v) { return __hip_atomic_fetch_add(p, v, __ATOMIC_RELAXED, __HIP_MEMORY_SCOPE_AGENT); }
__device__ __forceinline__ unsigned xb_xcc_id() { return (unsigned)__builtin_amdgcn_s_getreg((3 << 11) | 20) & 0xFu; }
#define XB_SPIN(cond, bar) do { unsigned _sp = 0; while (cond) { __builtin_amdgcn_s_sleep(1); \
    if ((++_sp & 255u) == 0u) { if (xb_ld(&(bar)[XB_TMO])) break; if (_sp > XB_SPIN_CAP) { atomicAdd(&(bar)[XB_TMO], 1u); break; } } } } while (0)

struct XcdBarrier {
    unsigned* bar; unsigned x;
    volatile LAS unsigned* st;
};

__device__ __forceinline__ XcdBarrier xcd_barrier_post(unsigned* bar, volatile LAS unsigned* st) {
    XcdBarrier b; b.bar = bar; b.x = xb_xcc_id(); b.st = st;
    if (threadIdx.x == 0) (void)xb_add(&bar[XB_XCNT(b.x)], 1u);
    return b;
}
__device__ __forceinline__ void xcd_barrier_complete(unsigned* bar, unsigned x, unsigned& nloc, unsigned& nx) {
    const unsigned G = gridDim.x * gridDim.y * gridDim.z;
    unsigned sum, cnt, mine, sp = 0u;
    for (;;) {
        sum = 0u; cnt = 0u; mine = 0u;
#pragma unroll
        for (unsigned j = 0; j < 16; ++j) { const unsigned c = xb_ld(&bar[XB_XCNT(j)]); sum += c; cnt += (c > 0u) ? 1u : 0u; mine = (j == x) ? c : mine; }
        if (sum == G) break;
        __builtin_amdgcn_s_sleep(1);
        if ((++sp & 255u) == 0u) { if (xb_ld(&bar[XB_TMO])) break; if (sp > XB_SPIN_CAP) { atomicAdd(&bar[XB_TMO], 1u); break; } }
    }
    nloc = mine > 0u ? mine : 1u; nx = cnt > 0u ? cnt : 1u;
}

__device__ __forceinline__ void xcd_barrier(const XcdBarrier& b) {
    asm volatile("s_waitcnt vmcnt(0)" ::: "memory");
    __syncthreads();
    if (threadIdx.x == 0) {
        unsigned* bar = b.bar;
        __builtin_amdgcn_s_waitcnt(0);
        unsigned nloc = b.st[0], nx = b.st[1];
        if (nloc == 0u) { xcd_barrier_complete(bar, b.x, nloc, nx); b.st[0] = nloc; b.st[1] = nx; }
        const unsigned old = xb_add(&bar[XB_XSUB(b.x)], 1u);
        const unsigned gen = old / nloc;
        if (old + 1u == (gen + 1u) * nloc) {
            __builtin_amdgcn_fence(__ATOMIC_RELEASE, "agent");
            asm volatile("s_waitcnt vmcnt(0)" ::: "memory");
            const unsigned og = xb_add(&bar[XB_TOP], 1u);
            const unsigned tg = og / nx;
            if (og + 1u == (tg + 1u) * nx) xb_add(&bar[XB_TOPGEN], 1u);
            else XB_SPIN(xb_ld(&bar[XB_TOPGEN]) == tg, bar);
            __builtin_amdgcn_fence(__ATOMIC_ACQUIRE, "agent");
            xb_add(&bar[XB_XGEN(b.x)], 1u);
            asm volatile("s_waitcnt vmcnt(0)" ::: "memory");
        } else {
            XB_SPIN(xb_ld(&bar[XB_XGEN(b.x)]) == gen, bar);
            __builtin_amdgcn_fence(__ATOMIC_ACQUIRE, "agent");
            asm volatile("s_waitcnt vmcnt(0)" ::: "memory");
        }
    }
    __syncthreads();
}
constexpr int LDS_BYTES = 133120;

__device__ __forceinline__ KP kargs() {
#if defined(__HIP_DEVICE_COMPILE__)
    KP p = (KP)__builtin_amdgcn_kernarg_segment_ptr(); asm volatile("" : "+s"(p)); return p;
#else
    return nullptr;
#endif
}
__device__ __forceinline__ void gsync1(cg::grid_group& grid) {
    asm volatile("s_waitcnt vmcnt(0) lgkmcnt(0)" ::: "memory");
    __syncthreads();
    if (threadIdx.x < 64) asm volatile("buffer_wbl2 sc1\n\ts_waitcnt vmcnt(0)" ::: "memory");
    grid.sync();
    asm volatile("buffer_inv sc1\n\ts_waitcnt vmcnt(0)" ::: "memory");
}
__device__ __forceinline__ void touch_weights(LAS unsigned char* lds, const unsigned char* w, size_t bytes, int G, int bx) {
    const int tid = ltid(), wid = __builtin_amdgcn_readfirstlane(tid >> 6); LAS unsigned* dst = (LAS unsigned*)(lds + wid * 256);
    const size_t nlines = bytes >> 7;
    for (size_t i = (size_t)bx * 512 + tid; i < nlines; i += (size_t)G * 512) __builtin_amdgcn_global_load_lds((const unsigned*)(w + (i << 7)), dst, 4, 0, 0);
}
constexpr int CONV_SPLIT = 1280;
constexpr size_t WS_BAR = 896 * 1024;
#ifdef EXP_SYNC2
#define gsync(grid) do { xcd_barrier(xbar); xcd_barrier(xbar); } while (0)
#else
#define gsync(grid) xcd_barrier(xbar)
#endif
#define PHASE_PTRS const KP kp = kargs(); \
    float* ss = (float*)(GP(unsigned char, 19) + WS_SS); float* xtail = (float*)(GP(unsigned char, 19) + WS_XTAIL); \
    bf16_t* xb = (bf16_t*)(GP(unsigned char, 19) + WS_XB); float* gk = (float*)(GP(unsigned char, 19) + WS_GK); bf16_t* mb = (bf16_t*)(GP(unsigned char, 19) + WS_GK); \
    bf16_t* a_in = (bf16_t*)(GP(unsigned char, 19) + WS_AIN); bf16_t* b_in = (bf16_t*)(GP(unsigned char, 19) + WS_BIN); bf16_t* obuf = (bf16_t*)(GP(unsigned char, 19) + WS_OB); \
    bf16_t* proj = (bf16_t*)(GP(unsigned char, 19) + WS_PROJ); bf16_t* hb = (bf16_t*)(GP(unsigned char, 19) + WS_PROJ); \
    unsigned char* wl = GP(unsigned char, 19) + WS_W + (size_t)l * W_LAYER; float* ossq = ss + 5 * M_ROWS + (size_t)l * M_ROWS * 4; \
    (void)ss; (void)xtail; (void)xb; (void)gk; (void)mb; (void)a_in; (void)b_in; (void)obuf; (void)proj; (void)hb; (void)wl; (void)ossq;
#ifndef DBG_CUT
#define DBG_CUT 0
#endif
__device__ __forceinline__ void dbg_dump(const KP kp, const bf16_t* b0, const bf16_t* b1) {
    float* out = GP(float, 18); const int gt = blockIdx.x * 512 + ltid(), NT = gridDim.x * 512;
    for (int i = gt; i < 16777216; i += NT) out[i] = bf2f(b0[i]);
    for (int i = gt; i < 16777216; i += NT) out[O_SGLA + 16777216 + i] = bf2f(b1[i]);
}
__global__ void __launch_bounds__(512, 2) fwd_kernel(Args a_unused) {
    extern __shared__ __attribute__((aligned(16))) unsigned char lds_raw[];
    LAS unsigned char* lds = (LAS unsigned char*)lds_raw;
    cg::grid_group grid = cg::this_grid();
    const int G = gridDim.x, bx = blockIdx.x;

    volatile LAS unsigned* xst = (volatile LAS unsigned*)(lds + 131072 + 64);
    if (threadIdx.x < 2) xst[threadIdx.x] = 0u;
    { const KP kp = kargs(); unsigned* bw = (unsigned*)(GP(unsigned char, 19) + WS_BAR);
      for (int i = bx * 512 + ltid(); i < XCD_BAR_WORDS; i += G * 512) bw[i] = 0u; }
    gsync1(grid);
    XcdBarrier xbar;
    { const KP kp = kargs(); xbar = xcd_barrier_post((unsigned*)(GP(unsigned char, 19) + WS_BAR), xst); }
    { const KP kp = kargs(); p0_prologue(kp, lds);
#ifdef EXP_P0x2
      __syncthreads(); p0_prologue(kp, lds);
#endif
    }
    gsync(grid);

    for (int l = 0; l < 2; ++l) {
#ifndef NO_PH_GEMM1
        { PHASE_PTRS pg8::Gemm g{xb, (const bf16_t*)wl, M_ROWS, NGEMM1, DM}; pg8::StaticOrder S; S.init(M_ROWS, NGEMM1, G, bx);
          pg8::EpiProj E{proj, gk, ss + (size_t)(2 * l) * M_ROWS, GP(const float, 8) + l * 512};
          pg8::gemm_phase<pg8::EpiProj, pg8::StaticOrder, true, true>(lds, g, S, E);
#ifdef EXP_G1x2
          gsync(grid); pg8::gemm_phase<pg8::EpiProj, pg8::StaticOrder, true, true>(lds, g, S, E);
#endif
#ifdef EXP_G1x3
          gsync(grid); pg8::gemm_phase<pg8::EpiProj, pg8::StaticOrder, true, true>(lds, g, S, E);
#endif
          }
#endif
        gsync(grid);
#if DBG_CUT == 8
        { const KP kp = kargs(); float* out = GP(float, 18); const bf16_t* pj = (const bf16_t*)(GP(unsigned char, 19) + WS_PROJ); const int gt = blockIdx.x * 512 + ltid(), NT = gridDim.x * 512;
          for (int i = gt; i < 2 * 16777216; i += NT) { const int row = i >> 11, col = 3072 + (i & 2047); if (row < M_ROWS) { const float v = bf2f(pj[(size_t)row * NPROJ + col]); if (i < 16777216) out[i] = v; else out[O_SGLA + i] = v; } } return; }
#endif
#if DBG_CUT == 7
        { const KP kp = kargs(); float* out = GP(float, 18); const float* g = (const float*)(GP(unsigned char, 19) + WS_GK); const int gt = blockIdx.x * 512 + ltid(), NT = gridDim.x * 512;
          for (int i = gt; i < M_ROWS * 512; i += NT) out[i] = g[i]; return; }
#endif
#if DBG_CUT == 1
        { const KP kp = kargs(); dbg_dump(kp, (const bf16_t*)(GP(unsigned char, 19) + WS_PROJ), (const bf16_t*)(GP(unsigned char, 19) + WS_PROJ) + 8192 * 4096); return; }
#endif
        { PHASE_PTRS unsigned char* g0 = GP(unsigned char, 19) + WS_G0;
          { GlaPre A, B;
#pragma unroll
            for (int i = 0; i < 2; ++i) { A.rq[i] = B.rq[i] = (u32x4){0u, 0u, 0u, 0u}; A.rk[i] = B.rk[i] = (u32x4){0u, 0u, 0u, 0u}; }
#pragma unroll
            for (int i = 0; i < 4; ++i) A.rg[i] = B.rg[i] = (u32x4){0u, 0u, 0u, 0u};
            int it = bx; if (it < 1056) gla_pre_load(A, it, proj, gk);
            while (it < 1056) { const int itn = it + G; if (itn < 1056) gla_pre_load(B, itn, proj, gk); gla_pre_item(lds, it, proj, gk, g0, A); A = B; it = itn; } }
          for (int it = bx; it < CONV_SPLIT; it += 2 * G) conv_prompt2(it, G, CONV_SPLIT, l, proj, GP(const float, 6), a_in, GP(float, 18) + O_PCONV); }
        gsync(grid);
        { PHASE_PTRS unsigned char* g0 = GP(unsigned char, 19) + WS_G0;
          const int ng = G >= 256 ? 128 : (G > 1 ? G / 2 : 1);
          if (bx < ng) { for (int item = bx; item < 128; item += ng) gla_seq_item(lds, item, proj, (unsigned char*)gk, g0, obuf, ossq, GP(float, 18) + O_PGLA + (size_t)l * 8 * 4 * 128 * 256); }
          if (bx >= ng || G == 1) { const int nb = G == 1 ? 1 : G - ng, b0 = G == 1 ? 0 : bx - ng;
              for (int it = b0; it < 512; it += nb) gla_sample_item(lds, it, l, proj, gk, GP(const float, 3), GP(float, 18) + O_SGLA, GP(const float, 9) + l * 256, b_in);
              for (int it = CONV_SPLIT + b0; it < NPROMPT / 4; it += 2 * nb) conv_prompt2(it, nb, NPROMPT / 4, l, proj, GP(const float, 6), a_in, GP(float, 18) + O_PCONV);
              for (int it = NPROMPT / 4 + b0; it < M_ROWS / 4; it += nb) conv_rows(it, l, proj, GP(const float, 6), GP(const float, 2), a_in, GP(float, 18) + O_PCONV, GP(float, 18) + O_SCONV); } }
        gsync(grid);
        { PHASE_PTRS for (int it = bx; it < NPROMPT / 4; it += 4 * G) prep_rows4(it, G, proj, obuf, ossq, GP(const float, 9) + l * 256, b_in);
          touch_weights(lds, wl + W_A, 6 * MiB, G, bx); }
        gsync(grid);
#if DBG_CUT == 3
        { const KP kp = kargs(); dbg_dump(kp, (const bf16_t*)(GP(unsigned char, 19) + WS_BIN), (const bf16_t*)(GP(unsigned char, 19) + WS_OB)); return; }
#endif
        { PHASE_PTRS pg8::Gemm g{a_in, (const bf16_t*)(wl + W_A), NREAL, DM, DM, b_in, (const bf16_t*)(wl + W_B)}; pg8::PairOrder S; S.init(NREAL, DM, G, bx);
          pg8::EpiGate2 E{proj + C_GA, proj + C_GBB, mb};
          pg8::gemm_phase<pg8::EpiGate2, pg8::PairOrder, true, true>(lds, g, S, E);
          TailGate<false> TA{proj + C_GA, mb}; tail_gemm(lds, a_in, (const bf16_t*)(wl + W_A), DM, TA);
          TailGate<true> TB{proj + C_GBB, mb}; tail_gemm(lds, b_in, (const bf16_t*)(wl + W_B), DM, TB);
          touch_weights(lds, wl + W_O, 2 * MiB, G, bx); }
        gsync(grid);
#if DBG_CUT == 4
        { const KP kp = kargs(); dbg_dump(kp, (const bf16_t*)(GP(unsigned char, 19) + WS_GK), (const bf16_t*)(GP(unsigned char, 19) + WS_BIN)); return; }
#endif
#ifndef NO_PH_GEMM3
        { PHASE_PTRS pg8::Gemm g{mb, (const bf16_t*)(wl + W_O), NREAL, DM, DM}; pg8::StaticOrder S; S.init(NREAL, DM, G, bx);
          pg8::EpiResid E{xb, ss + (size_t)(2 * l + 1) * M_ROWS};
          pg8::gemm_phase<pg8::EpiResid, pg8::StaticOrder, true, true>(lds, g, S, E);
          TailResid TE{xb, ss + (size_t)(2 * l + 1) * M_ROWS}; tail_gemm(lds, mb, (const bf16_t*)(wl + W_O), DM, TE);
          touch_weights(lds, wl + W_GU, 11 * MiB, G, bx); }
#endif
        gsync(grid);
#if DBG_CUT == 5
        { const KP kp = kargs(); dbg_dump(kp, (const bf16_t*)(GP(unsigned char, 19) + WS_XB), (const bf16_t*)(GP(unsigned char, 19) + WS_GK)); return; }
#endif
#ifndef NO_PH_GEMM4
        { PHASE_PTRS pg8::Gemm g{xb, (const bf16_t*)(wl + W_GU), M_ROWS, 2 * DFF, DM}; pg8::StaticOrder S; S.init(M_ROWS, 2 * DFF, G, bx);
          pg8::EpiSwiglu E{hb, ss + (size_t)(2 * l + 1) * M_ROWS};
          pg8::gemm_phase<pg8::EpiSwiglu, pg8::StaticOrder, true, true>(lds, g, S, E);
#ifdef EXP_G4x2
          gsync(grid); pg8::gemm_phase<pg8::EpiSwiglu, pg8::StaticOrder, true, true>(lds, g, S, E);
#endif
          }
#endif
        gsync(grid);
#if DBG_CUT == 6
        { const KP kp = kargs(); dbg_dump(kp, (const bf16_t*)(GP(unsigned char, 19) + WS_PROJ), (const bf16_t*)(GP(unsigned char, 19) + WS_PROJ) + 16777216); return; }
#endif
#ifndef NO_PH_GEMM5
        { PHASE_PTRS pg8::Gemm g{hb, (const bf16_t*)(wl + W_D), NREAL, DM, DFF}; pg8::StaticOrder S; S.init(NREAL, DM, G, bx);
          pg8::EpiResid E{xb, ss + (size_t)(2 * l + 2) * M_ROWS};
          pg8::gemm_phase<pg8::EpiResid, pg8::StaticOrder, true, true>(lds, g, S, E);
          TailResid TE{xb, ss + (size_t)(2 * l + 2) * M_ROWS}; tail_gemm(lds, hb, (const bf16_t*)(wl + W_D), DFF, TE);
          if (l == 0) touch_weights(lds, wl + W_LAYER, 17 * MiB, G, bx); }
#endif
        gsync(grid);
    }
    { const int l = 0; PHASE_PTRS const float* ssf = ss + (size_t)4 * M_ROWS; const int gt = bx * 512 + ltid(), NT = G * 512;
      for (int i0 = gt; i0 < (NREAL + 128) * 256; i0 += 4 * NT) { u32x2 v[4]; float sv[4]; float* dst[4]; int c4s[4];
#pragma unroll
          for (int u = 0; u < 4; ++u) { const int i = i0 + u * NT; dst[u] = nullptr; if (i < (NREAL + 128) * 256) { int row = i >> 8; const int c4 = (i & 255) * 4; c4s[u] = c4;
              if (row < NREAL) dst[u] = GP(float, 18) + (size_t)row * DM + c4;
              else { const int s = row - NREAL; row = NPROMPT + s; dst[u] = GP(float, 18) + O_YS + (size_t)s * DM + c4; }
              v[u] = __builtin_nontemporal_load((const u32x2*)(xb + (size_t)row * DM + c4)); sv[u] = ssf[row]; } }
#pragma unroll
          for (int u = 0; u < 4; ++u) if (dst[u]) { const float rs = rsqrtf(sv[u] * (1.f / DM) + EPS); const f32x4 fn = *(const f32x4*)(GP(const float, 17) + c4s[u]);
              const f32x4 x = {bflo(v[u].x), bfhi(v[u].x), bflo(v[u].y), bfhi(v[u].y)}; __builtin_nontemporal_store(x * rs * fn, (f32x4*)dst[u]); } } }
}

extern "C" void kernel_launch(void* const* d_in, const int* in_sizes, int n_in, void* d_out, int out_size, void* d_ws, size_t ws_size, hipStream_t stream) {
    static int grid = 0;
    if (grid == 0) {
        if (n_in != 18 || ws_size < WS_END) { fprintf(stderr, "kernel_launch: expected 18 inputs and >= %zu bytes of workspace (got %d, %zu)\n", (size_t)WS_END, n_in, ws_size); grid = -1; return; }
        int dev = 0, cus = 0, per_cu = 0;
        if (hipGetDevice(&dev) != hipSuccess || hipDeviceGetAttribute(&cus, hipDeviceAttributeMultiprocessorCount, dev) != hipSuccess) { grid = -1; return; }
        if (hipFuncSetAttribute((const void*)fwd_kernel, hipFuncAttributeMaxDynamicSharedMemorySize, LDS_BYTES) != hipSuccess) { fprintf(stderr, "kernel_launch: hipFuncSetAttribute failed\n"); grid = -1; return; }
        if (hipOccupancyMaxActiveBlocksPerMultiprocessor(&per_cu, (const void*)fwd_kernel, 512, LDS_BYTES) != hipSuccess || per_cu < 1) { fprintf(stderr, "kernel_launch: occupancy query gave %d\n", per_cu); per_cu = 1; }
        (void)hipGetLastError();
        grid = cus;
    }
    if (grid < 0) return;
    Args a{};
    a.x_prompt = (const float*)d_in[0]; a.x_sample = (const float*)d_in[1]; a.state_conv = (const float*)d_in[2]; a.state_gla = (const float*)d_in[3]; a.meta = (const float*)d_in[4];
    a.w_in = (const float*)d_in[5]; a.conv_w = (const float*)d_in[6]; a.w_gk2 = (const float*)d_in[7]; a.b_gk2 = (const float*)d_in[8]; a.gla_gain = (const float*)d_in[9];
    a.w_a = (const float*)d_in[10]; a.w_b = (const float*)d_in[11]; a.w_o = (const float*)d_in[12]; a.norm_mix = (const float*)d_in[13]; a.norm_ffn = (const float*)d_in[14];
    a.w_gu = (const float*)d_in[15]; a.w_down = (const float*)d_in[16]; a.final_norm = (const float*)d_in[17];
    a.out = (float*)d_out; a.ws = (unsigned char*)d_ws;
    void* args[] = {&a};
    hipError_t e = hipLaunchCooperativeKernel((const void*)fwd_kernel, dim3(grid), dim3(512), args, LDS_BYTES, stream);
    if (e != hipSuccess) fprintf(stderr, "kernel_launch: cooperative launch failed: %s (grid %d)\n", hipGetErrorString(e), grid);
}
```
